# Optimizing an MI355X kernel written in HIP

```python
import jax, jax.numpy as jnp
from jax import lax
import numpy as np

D_MODEL = 2048
BATCH = 8
SEQ = 4096
DEPTH = 4
DEC_BATCH = 4
DEC_SEQ = 4096
PAST_LEN = 128

GRID_W = 64
A_HEAD_DIM = 64
A_HEADS = (D_MODEL // 2) // A_HEAD_DIM
A_W = A_HEADS * A_HEAD_DIM
A_DECAY_LORA = 64
A_ICLR_LORA = 64
A_GATE_LORA = 128
A_COLS = 3 * A_W + A_DECAY_LORA + A_ICLR_LORA + A_GATE_LORA
A_GN_EPS = 64e-5
B_HEAD_DIM = 64
B_HEADS = (D_MODEL // 2) // B_HEAD_DIM
B_W = B_HEADS * B_HEAD_DIM
NA_ROWS = 8
NA_COLS = 16
NA_QBLOCK = 16
NA_SPAN = 2 * NA_COLS
AB_IN = A_COLS + 3 * B_W
AB_OUT_IN = A_W + B_W
C_HEADS = 8
C_QK_DIM = D_MODEL // C_HEADS
C_V_DIM = 2 * C_QK_DIM
C_QK = C_HEADS * C_QK_DIM
C_V = C_HEADS * C_V_DIM
C_IN = 2 * C_QK + 2 * C_V
RET_CHUNK = 128
ROPE_BASE = 10000.0
D_FF = ((8 * D_MODEL // 3 + 127) // 128) * 128
CONV_W = 3
DN_ALPHA = (2.0 * DEPTH) ** 0.25
DN_BETA = (8.0 * DEPTH) ** -0.25
LN_EPS = 1e-5
N_EVEN = (DEPTH + 1) // 2
N_ODD = DEPTH // 2
NEG_INF = -1e30

kernel_name = 'bidir_rwkv7_natten_retnet_encoder'


def layer_norm(x, g, b):
    xf = x.astype(jnp.float32)
    mu = xf.mean(-1, keepdims=True)
    var = jnp.square(xf - mu).mean(-1, keepdims=True)
    return ((xf - mu) * lax.rsqrt(var + LN_EPS) * g + b).astype(x.dtype)


def head_group_norm(y, g, b, eps):
    bn, s, h, d = y.shape
    mu = y.mean(-1, keepdims=True)
    var = jnp.square(y - mu).mean(-1, keepdims=True)
    return ((y - mu) * lax.rsqrt(var + eps)).reshape(bn, s, h * d) * g + b


def centred_dwconv3(h, w):
    prev = jnp.pad(h[:, :-1], ((0, 0), (1, 0), (0, 0)))
    nxt = jnp.pad(h[:, 1:], ((0, 0), (0, 1), (0, 0)))
    return w[0] * prev + w[1] * h + w[2] * nxt


def rotary(x, pos):
    half = x.shape[-1] // 2
    inv = ROPE_BASE ** (-jnp.arange(half, dtype=jnp.float32) / half)
    ang = pos[:, None] * inv[None, :]
    cos = jnp.cos(ang)[:, None, :]
    sin = jnp.sin(ang)[:, None, :]
    x1, x2 = x[..., :half], x[..., half:]
    return jnp.concatenate([x1 * cos - x2 * sin, x1 * sin + x2 * cos], axis=-1)


def rwkv7_scan(r, decay, k, v, kk, a, reverse):
    bn, s, h, n = r.shape

    def step(state, inp):
        r_t, w_t, k_t, v_t, kk_t, a_t = inp
        sa = jnp.einsum('bhij,bhj->bhi', state, -kk_t)
        new = (state * w_t[:, :, None, :]
               + sa[..., None] * (kk_t * a_t)[:, :, None, :]
               + v_t[..., None] * k_t[:, :, None, :])
        read = state if reverse else new
        return new, jnp.einsum('bhij,bhj->bhi', read, r_t)

    xs = tuple(jnp.moveaxis(t, 1, 0) for t in (r, decay, k, v, kk, a))
    s0 = jnp.zeros((bn, h, n, n), jnp.float32)
    _, ys = lax.scan(step, s0, xs, reverse=reverse)
    return jnp.moveaxis(ys, 0, 1)


def rwkv7_mix(ha, w0, w_up, a0, a_up, g_up, k_k, k_a, r_k, gn_g, gn_b):
    bn, s, _ = ha.shape
    haf = ha.astype(jnp.float32)
    r = haf[..., :A_W]
    k = haf[..., A_W:2 * A_W]
    v = haf[..., 2 * A_W:3 * A_W]
    o = 3 * A_W
    w_lo = haf[..., o:o + A_DECAY_LORA]
    o += A_DECAY_LORA
    a_lo = haf[..., o:o + A_ICLR_LORA]
    o += A_ICLR_LORA
    g_lo = haf[..., o:o + A_GATE_LORA]

    def heads(t):
        return t.reshape(bn, s, A_HEADS, A_HEAD_DIM)

    gate = jax.nn.sigmoid(g_lo) @ g_up
    kk = heads(k * k_k)
    kk = kk / jnp.maximum(jnp.linalg.norm(kk, axis=-1, keepdims=True), 1e-12)
    w_act = jnp.tanh(w_lo)

    def direction(d, reverse):
        w_log = -jax.nn.softplus(-(w0[d] + w_act @ w_up[d])) - 0.5
        decay = jnp.exp(-jnp.exp(w_log))
        a = jax.nn.sigmoid(a0[d] + a_lo @ a_up[d])
        k_d = k * (1.0 + (a - 1.0) * k_a)
        y_d = rwkv7_scan(heads(r), heads(decay), heads(k_d), heads(v), kk, heads(a), reverse)
        return y_d, k_d

    y_f, k_f = direction(0, False)
    y_b, _ = direction(1, True)
    y = head_group_norm(y_f + y_b, gn_g, gn_b, A_GN_EPS)
    bonus = (jnp.sum(heads(r) * heads(k_f) * r_k, axis=-1, keepdims=True) * heads(v)).reshape(bn, s, A_W)
    return ((y + bonus) * gate).astype(ha.dtype)


def na_static(wr):
    nb = GRID_W // NA_QBLOCK
    qcol = np.arange(nb)[:, None] * NA_QBLOCK + np.arange(NA_QBLOCK)[None, :]
    span0 = np.clip(np.arange(nb) * NA_QBLOCK - NA_COLS // 2, 0, GRID_W - NA_SPAN)
    kcol = span0[:, None] + np.arange(NA_SPAN)[None, :]
    cs = np.clip(qcol - NA_COLS // 2, 0, GRID_W - NA_COLS)
    valid = (kcol[:, None, :] >= cs[:, :, None]) & (kcol[:, None, :] < cs[:, :, None] + NA_COLS)
    col_off = np.clip(kcol[:, None, :] - qcol[:, :, None], -(NA_COLS - 1), NA_COLS - 1) + NA_COLS - 1
    mask = np.broadcast_to(valid[:, :, None, :], (nb, NA_QBLOCK, wr, NA_SPAN)).reshape(nb, NA_QBLOCK, wr * NA_SPAN)
    return kcol, col_off, mask


def neighbourhood_attention(hb, rpb):
    bn, s, _ = hb.shape
    rows = s // GRID_W
    wr = min(NA_ROWS, rows)
    nb = GRID_W // NA_QBLOCK
    kcol, col_off, mask = na_static(wr)

    def grid(t):
        return t.reshape(bn, rows, GRID_W, B_HEADS, B_HEAD_DIM)

    q = grid(hb[..., :B_W])
    k = grid(hb[..., B_W:2 * B_W])
    v = grid(hb[..., 2 * B_W:])
    scale = B_HEAD_DIM ** -0.5

    def gather_keys(t, rs):
        t = lax.dynamic_slice_in_dim(t, rs, wr, axis=1)[:, :, kcol]
        return t.transpose(0, 2, 1, 3, 4, 5).reshape(bn, nb, wr * NA_SPAN, B_HEADS, B_HEAD_DIM)

    def row_block(r):
        rs = jnp.clip(r - wr // 2, 0, rows - wr)
        qr = lax.dynamic_index_in_dim(q, r, axis=1, keepdims=False).reshape(bn, nb, NA_QBLOCK, B_HEADS, B_HEAD_DIM)
        kb = gather_keys(k, rs)
        vb = gather_keys(v, rs)
        row_off = rs - r + jnp.arange(wr) + NA_ROWS - 1
        bias = rpb[:, row_off][:, :, col_off]
        bias = bias.transpose(0, 2, 3, 1, 4).reshape(B_HEADS, nb, NA_QBLOCK, wr * NA_SPAN)
        sc = jnp.einsum('bnqhd,bnkhd->bhnqk', qr, kb).astype(jnp.float32) * scale + bias.astype(jnp.float32)
        sc = jnp.where(mask, sc, NEG_INF)
        p = jax.nn.softmax(sc, axis=-1).astype(vb.dtype)
        return jnp.einsum('bhnqk,bnkhd->bnqhd', p, vb).reshape(bn, GRID_W, B_W)

    out = lax.map(row_block, jnp.arange(rows))
    return out.transpose(1, 0, 2, 3).reshape(bn, s, B_W)


def mixer_ab(x, w_in, shift, w0, w_up, a0, a_up, g_up, k_k, k_a, r_k, gn_g, gn_b, rpb, w_out):
    h = x @ w_in
    ya = rwkv7_mix(centred_dwconv3(h[..., :A_COLS], shift), w0, w_up, a0, a_up, g_up, k_k, k_a, r_k, gn_g, gn_b)
    yb = neighbourhood_attention(h[..., A_COLS:], rpb)
    return jnp.concatenate([ya, yb], axis=-1) @ w_out


def retention_direction(q, k, v, log_gamma, inclusive):
    bn, s, h, dk = q.shape
    dv = v.shape[-1]
    c = RET_CHUNK
    n = s // c

    def chunks(t):
        return t.reshape(bn, n, c, h, t.shape[-1]).transpose(1, 0, 3, 2, 4)

    pos = jnp.arange(c, dtype=jnp.float32)
    diff = pos[:, None] - pos[None, :]
    keep = (diff >= 0) if inclusive else (diff > 0)
    intra = jnp.where(keep[None], jnp.exp(log_gamma[:, None, None] * jnp.maximum(diff, 0.0)[None]), 0.0)
    q_dec = jnp.exp(log_gamma[:, None] * (pos + 1.0)[None])[..., None]
    k_dec = jnp.exp(log_gamma[:, None] * (c - 1.0 - pos)[None])[..., None]
    c_dec = jnp.exp(log_gamma * c)[:, None, None]

    def step(state, inp):
        qc, kc, vc = inp
        sc = jnp.einsum('bhqd,bhkd->bhqk', qc, kc) * intra
        o = jnp.einsum('bhqk,bhkv->bhqv', sc, vc) + jnp.einsum('bhqd,bhdv->bhqv', qc * q_dec, state)
        state = state * c_dec + jnp.einsum('bhkd,bhkv->bhdv', kc * k_dec, vc)
        return state, o

    s0 = jnp.zeros((bn, h, dk, dv), jnp.float32)
    _, out = lax.scan(step, s0, (chunks(q), chunks(k), chunks(v)))
    return out.transpose(1, 0, 3, 2, 4).reshape(bn, s, h, dv)


def mixer_c(x, w_in, gn_g, gn_b, w_out):
    bn, s, _ = x.shape
    h = (x @ w_in).astype(jnp.float32)
    q = h[..., :C_QK].reshape(bn, s, C_HEADS, C_QK_DIM)
    k = h[..., C_QK:2 * C_QK].reshape(bn, s, C_HEADS, C_QK_DIM)
    v = h[..., 2 * C_QK:2 * C_QK + C_V].reshape(bn, s, C_HEADS, C_V_DIM)
    g = h[..., 2 * C_QK + C_V:]
    pos = jnp.arange(s, dtype=jnp.float32)
    q = rotary(q, pos)
    k = rotary(k, pos) * (C_QK_DIM ** -0.5)
    log_gamma = jnp.log(1.0 - jnp.power(2.0, -5.0 - jnp.arange(C_HEADS, dtype=jnp.float32)))
    y_f = retention_direction(q, k, v, log_gamma, True)
    y_b = jnp.flip(retention_direction(jnp.flip(q, 1), jnp.flip(k, 1), jnp.flip(v, 1), log_gamma, False), 1)
    y = head_group_norm(y_f + y_b, gn_g, gn_b, LN_EPS)
    return (jax.nn.silu(g) * y).astype(x.dtype) @ w_out


def conv_ffn(x, w_up, conv_w, conv_b, w_down):
    h = x @ w_up
    gate = centred_dwconv3(h[..., :D_FF], conv_w) + conv_b
    return (jax.nn.gelu(gate, approximate=False) * h[..., D_FF:]) @ w_down


def run_trunk(x, ab_w_in, ab_shift, ab_w0, ab_w_up, ab_a0, ab_a_up, ab_g_up, ab_k_k, ab_k_a, ab_r_k,
              ab_gn_g, ab_gn_b, ab_rpb, ab_w_out, c_w_in, c_gn_g, c_gn_b, c_w_out,
              ln1_g, ln1_b, ffn_w_up, ffn_conv, ffn_conv_b, ffn_w_down, ln2_g, ln2_b):
    for l in range(DEPTH):
        e = l // 2
        if l % 2 == 0:
            mix = mixer_ab(x, ab_w_in[e], ab_shift[e], ab_w0[e], ab_w_up[e], ab_a0[e], ab_a_up[e], ab_g_up[e],
                           ab_k_k[e], ab_k_a[e], ab_r_k[e], ab_gn_g[e], ab_gn_b[e], ab_rpb[e], ab_w_out[e])
        else:
            mix = mixer_c(x, c_w_in[e], c_gn_g[e], c_gn_b[e], c_w_out[e])
        x = layer_norm(DN_ALPHA * x + mix, ln1_g[l], ln1_b[l])
        x = layer_norm(DN_ALPHA * x + conv_ffn(x, ffn_w_up[l], ffn_conv[l], ffn_conv_b[l], ffn_w_down[l]),
                       ln2_g[l], ln2_b[l])
    return x


def setup_inputs(seed: int = 0) -> dict:
    key = jax.random.key(seed)
    ks = iter(jax.random.split(key, 40))

    def nrm(shape, scale):
        return jax.random.normal(next(ks), shape, jnp.float32) * scale

    ne, no = N_EVEN, N_ODD
    ramp = (jnp.arange(A_W, dtype=jnp.float32) / (A_W - 1)) ** 0.9
    shift_base = jnp.array([0.25, 0.5, 0.25], jnp.float32)[:, None]
    conv_base = jnp.array([0.2, 0.6, 0.2], jnp.float32)[:, None]
    return {
        'x_prompt': nrm((BATCH, SEQ, D_MODEL), 1.0),
        'x_sample': nrm((DEC_BATCH, DEC_SEQ, D_MODEL), 1.0),
        'ab_w_in': nrm((ne, D_MODEL, AB_IN), D_MODEL ** -0.5),
        'ab_shift': shift_base + nrm((ne, CONV_W, A_COLS), 0.05),
        'ab_w0': -6.0 + 5.0 * ramp + nrm((ne, 2, A_W), 0.1),
        'ab_w_up': nrm((ne, 2, A_DECAY_LORA, A_W), 0.1 * A_DECAY_LORA ** -0.5),
        'ab_a0': nrm((ne, 2, A_W), 0.1),
        'ab_a_up': nrm((ne, 2, A_ICLR_LORA, A_W), A_ICLR_LORA ** -0.5),
        'ab_g_up': nrm((ne, A_GATE_LORA, A_W), A_GATE_LORA ** -0.5),
        'ab_k_k': 0.85 + nrm((ne, A_W), 0.02),
        'ab_k_a': 1.0 + nrm((ne, A_W), 0.02),
        'ab_r_k': nrm((ne, A_HEADS, A_HEAD_DIM), 0.1),
        'ab_gn_g': 1.0 + nrm((ne, A_W), 0.02),
        'ab_gn_b': nrm((ne, A_W), 0.02),
        'ab_rpb': nrm((ne, B_HEADS, 2 * NA_ROWS - 1, 2 * NA_COLS - 1), 0.02),
        'ab_w_out': nrm((ne, AB_OUT_IN, D_MODEL), DN_BETA * AB_OUT_IN ** -0.5),
        'c_w_in': nrm((no, D_MODEL, C_IN), D_MODEL ** -0.5),
        'c_gn_g': 1.0 + nrm((no, C_V), 0.02),
        'c_gn_b': nrm((no, C_V), 0.02),
        'c_w_out': nrm((no, C_V, D_MODEL), DN_BETA * C_V ** -0.5),
        'ln1_g': 1.0 + nrm((DEPTH, D_MODEL), 0.02),
        'ln1_b': nrm((DEPTH, D_MODEL), 0.02),
        'ffn_w_up': nrm((DEPTH, D_MODEL, 2 * D_FF), D_MODEL ** -0.5),
        'ffn_conv': conv_base + nrm((DEPTH, CONV_W, D_FF), 0.05),
        'ffn_conv_b': nrm((DEPTH, D_FF), 0.02),
        'ffn_w_down': nrm((DEPTH, D_FF, D_MODEL), DN_BETA * D_FF ** -0.5),
        'ln2_g': 1.0 + nrm((DEPTH, D_MODEL), 0.02),
        'ln2_b': nrm((DEPTH, D_MODEL), 0.02),
    }


def reference(x_prompt, x_sample, ab_w_in, ab_shift, ab_w0, ab_w_up, ab_a0, ab_a_up, ab_g_up, ab_k_k, ab_k_a,
              ab_r_k, ab_gn_g, ab_gn_b, ab_rpb, ab_w_out, c_w_in, c_gn_g, c_gn_b, c_w_out,
              ln1_g, ln1_b, ffn_w_up, ffn_conv, ffn_conv_b, ffn_w_down, ln2_g, ln2_b):
    weights = (ab_w_in, ab_shift, ab_w0, ab_w_up, ab_a0, ab_a_up, ab_g_up, ab_k_k, ab_k_a, ab_r_k,
               ab_gn_g, ab_gn_b, ab_rpb, ab_w_out, c_w_in, c_gn_g, c_gn_b, c_w_out,
               ln1_g, ln1_b, ffn_w_up, ffn_conv, ffn_conv_b, ffn_w_down, ln2_g, ln2_b)
    y_prompt = run_trunk(x_prompt, *weights)
    y_sample = run_trunk(x_sample, *weights)
    return (y_prompt, y_sample)
```

```cpp
#include <hip/hip_runtime.h>
#include <cstdio>
#include <cstdint>

#ifndef MK_MULTI_LAUNCH
#define MK_MULTI_LAUNCH 0
#endif

#define GAS __attribute__((address_space(1)))
#define LAS __attribute__((address_space(3)))
typedef unsigned short bf16_t;
typedef short bf16x8 __attribute__((ext_vector_type(8)));
typedef float f32x4 __attribute__((ext_vector_type(4)));
typedef float f32x2 __attribute__((ext_vector_type(2)));
typedef unsigned u32x4 __attribute__((ext_vector_type(4)));
typedef unsigned u32x2 __attribute__((ext_vector_type(2)));
typedef GAS unsigned gu32;
#define RLX_AGENT __ATOMIC_RELAXED, __HIP_MEMORY_SCOPE_AGENT
#define DI __device__ __forceinline__

constexpr int D = 2048, SEQ = 4096, NSEQ = 12, T = NSEQ * SEQ;
constexpr int A_W = 1024, A_COLS = 3328, AB_IN = 6400, B_W = 1024, NB_COLS = 3072;
constexpr int C_QK = 2048, C_V = 4096, C_IN = 12288;
constexpr int D_FF = 5504, FF2 = 11008;
constexpr int DEPTH = 4;
constexpr float DN_ALPHA = 1.6817928305074290f;
constexpr float LN_EPS = 1e-5f, A_GN_EPS = 64e-5f;
constexpr int GRID_W = 64;
constexpr int LORA_K = 256, LORA_N = 5120;
constexpr int OG_SEQ = 2, OG_T = OG_SEQ * SEQ, OG_N = NSEQ / OG_SEQ, RC = 256, RNC = SEQ / RC, OG_ITEMS = OG_SEQ * 8 * RNC;
constexpr int CATK = 768;
constexpr int FG_SEQ = 4, FG_T = FG_SEQ * SEQ, FG_N = NSEQ / FG_SEQ;

constexpr size_t MiB = 1u << 20;
constexpr size_t WS_CTL = 0, CTL_ZERO_BYTES = 1 * MiB;
constexpr size_t WS_ROPE_N = 1 * MiB;
constexpr size_t WS_ROPE_T = 5 * MiB;
constexpr size_t WS_W = 9 * MiB;
constexpr size_t WE_IN = WS_W, WE_OUT = WE_IN + (size_t)AB_IN * D * 2, WE_UP = WE_OUT + (size_t)D * D * 2, WE_DN = WE_UP + (size_t)FF2 * D * 2, WE_LORA = WE_DN + (size_t)D * D_FF * 2, WE_END = WE_LORA + (size_t)LORA_N * LORA_K * 2;
constexpr int CIN_ROWS = 14336;
constexpr size_t WO_IN = WS_W, WO_OUT = WO_IN + (size_t)CIN_ROWS * D * 2, WO_UP = WO_OUT + (size_t)D * C_V * 2, WO_DN = WO_UP + (size_t)FF2 * D * 2, WO_END = WO_DN + (size_t)D * D_FF * 2;
constexpr size_t WS_XB = 146 * MiB;
constexpr size_t WS_POOL = 338 * MiB;
static_assert(WE_END <= WS_XB && WO_END <= WS_XB, "weights region");
constexpr size_t WS_YAB = WS_XB;
constexpr size_t WS_HA = WS_POOL;
constexpr size_t WS_HB = WS_HA + (size_t)T * A_COLS * 2;
constexpr size_t WS_EWA = WS_HB + (size_t)T * NB_COLS * 2;
constexpr size_t WS_EWA_END = WS_EWA + (size_t)4 * T * A_W * 2;
constexpr size_t WS_LIN = WS_EWA_END;
constexpr size_t WS_GATE = WS_HA;
constexpr size_t WS_YF = WS_HA + (size_t)T * A_W * 2;
constexpr size_t WS_YBK = WS_YF + (size_t)T * A_W * 2;
constexpr size_t WS_EVEN_END = WS_LIN + (size_t)T * LORA_K * 2;
constexpr size_t WS_HFF = WS_POOL;
constexpr size_t WS_ACT = WS_HFF + (size_t)FG_T * FF2 * 2;
constexpr size_t WS_FFN_END = WS_ACT + (size_t)FG_T * D_FF * 2;
constexpr size_t WS_QN = WS_POOL;
constexpr size_t WS_KN = WS_QN + (size_t)OG_T * C_QK * 2;
constexpr size_t WS_GS = WS_KN + (size_t)OG_T * C_QK * 2;
constexpr size_t WS_ACAT = WS_GS + (size_t)OG_T * C_V * 2;
constexpr size_t WS_BCAT = WS_ACAT + (size_t)OG_ITEMS * 256 * CATK * 2;
constexpr size_t WS_KTF = WS_BCAT + (size_t)OG_ITEMS * 512 * CATK * 2;
constexpr size_t WS_KTB = WS_KTF + (size_t)C_QK * OG_T * 2;
constexpr size_t WS_KVF = WS_KTB + (size_t)C_QK * OG_T * 2;
constexpr size_t WS_KVB = WS_KVF + (size_t)OG_ITEMS * 512 * 256 * 4;
constexpr size_t WS_Y = WS_KVB + (size_t)OG_ITEMS * 512 * 256 * 4;
constexpr size_t WS_OB = WS_Y + (size_t)OG_T * C_V * 4;
constexpr size_t WS_ODD_END = WS_OB + (size_t)OG_T * C_V * 2;
constexpr size_t WS_NEED = 1376 * MiB;
static_assert(WS_EVEN_END <= WS_NEED && WS_FFN_END <= WS_NEED && WS_ODD_END <= WS_NEED, "d_ws map");
constexpr int CW_TMO = 0, CW_BAR = 4096;

constexpr int RING_BYTES = 131072;
constexpr int LDSCTL_OFF = RING_BYTES, MISC_OFF = LDSCTL_OFF + 320;
constexpr int LDS_BYTES = 147456;
constexpr int NWAVES = 8;

DI unsigned f2bf(float f) { unsigned u = __builtin_bit_cast(unsigned, f); return (u + 0x7fffu + ((u >> 16) & 1u)) >> 16; }
DI unsigned pk2(float lo, float hi) { return f2bf(lo) | (f2bf(hi) << 16); }
DI float bf2f(unsigned short b) { return __builtin_bit_cast(float, ((unsigned)b) << 16); }
DI float bflo(unsigned w) { return __builtin_bit_cast(float, w << 16); }
DI float bfhi(unsigned w) { return __builtin_bit_cast(float, w & 0xffff0000u); }
DI unsigned cvt_pk_bf16(float lo, float hi) { unsigned r; asm volatile("v_cvt_pk_bf16_f32 %0, %1, %2" : "=v"(r) : "v"(lo), "v"(hi)); return r; }
DI unsigned pk2h(float lo, float hi) { typedef _Float16 h2 __attribute__((ext_vector_type(2))); h2 v; v.x = (_Float16)lo; v.y = (_Float16)hi; return __builtin_bit_cast(unsigned, v); }
DI float h2f(unsigned short h) { return (float)__builtin_bit_cast(_Float16, h); }
DI float wave_sum(float v) {
#pragma unroll
    for (int o = 1; o < 64; o <<= 1) v += __shfl_xor(v, o);
    return v;
}
template <class P> DI P* opaque_ptr(P* p) { asm volatile("" : "+s"(p)); return p; }
DI float sigmoidf_(float x) { return 1.0f / (1.0f + __expf(-x)); }

namespace pg8 {
constexpr int BM = 256, BK = 64, HALF = 128, HTB = HALF * BK * 2, STAGE_BYTES = 8 * HTB, NXCD = 8, WGM = 8;
DI int lds_byte(int r, int c) { const int st = (r >> 4) * 2 + (c >> 5), rr = r & 15, cc = c & 31, ob = rr * 64 + cc * 2; return st * 1024 + (ob ^ (((ob >> 9) & 1) << 5)); }
DI void stage_rc(int b, int& R, int& C) { const int st = b / 1024, sb = b % 1024, swz = sb ^ (((sb >> 9) & 1) << 5); R = (st >> 1) * 16 + swz / 64; C = (st & 1) * 32 + (swz % 64) / 2; }
DI int perm32(int rho) { const int n = rho >> 4, i = rho & 15; return 8 * (i >> 2) + 4 * n + (i & 3); }

struct Unit { int pm, pn, item; const char* a; const char* b; };
struct Gemm { int lda, ldb, K; };

struct FlatOrder {
    const char* A; const char* Bt; int lda, ldb; int nM, nN, nwg, G, c;
    DI void init(const void* A_, const void* Bt_, int lda_, int ldb_, int M, int N, int G_, int c_) { A = (const char*)A_; Bt = (const char*)Bt_; lda = lda_; ldb = ldb_; nM = M / BM; nN = N / BM; nwg = nM * nN; G = G_; c = c_; }
    DI bool next(int i, Unit& u) const {
        const long L = (long)i * G + c; if (L >= nwg) return false;
        int wgid = (int)L; { const int q = nwg / NXCD, r = nwg % NXCD, xcd = wgid % NXCD, off = wgid / NXCD; wgid = (xcd < r ? xcd * (q + 1) : r * (q + 1) + (xcd - r) * q) + off; }
        const int nig = WGM * nN, gid = wgid / nig, fm = gid * WGM, gsz = (nM - fm) < WGM ? (nM - fm) : WGM;
        u.pm = fm + ((wgid % nig) % gsz); u.pn = (wgid % nig) / gsz; u.item = 0;
        u.a = A + (size_t)u.pm * BM * lda * 2; u.b = Bt + (size_t)u.pn * BM * ldb * 2; return true;
    }
};

#define PG8_WAIT_V(n) asm volatile("s_waitcnt vmcnt(" #n ")" ::: "memory")
#define PG8_WAIT_L(n) asm volatile("s_waitcnt lgkmcnt(" #n ")" ::: "memory")
#define PG8_BAR __builtin_amdgcn_s_barrier()
#define PG8_SCHED __builtin_amdgcn_sched_barrier(0)

template <class Epi, class Sched>
DI void gemm_phase(LAS unsigned char* lds, const Gemm g, const Sched& S, const Epi& E, const int tid) {
    const int wid = __builtin_amdgcn_readfirstlane(tid >> 6), lane = tid & 63, wr = wid >> 2, wc = wid & 3, fr = lane & 15, fq = lane >> 4;
    int K = g.K; asm volatile("" : "+s"(K));
    const int nt = K / BK;
    unsigned voffA[2], voffB[2];
#pragma unroll
    for (int i = 0; i < 2; ++i) { int R, C; stage_rc(tid * 16 + i * 8192, R, C); const int Rb = Epi::PERM ? ((R & ~31) + perm32(R & 31)) : R;
        voffA[i] = (unsigned)(R * g.lda + C) * 2u; voffB[i] = (unsigned)(Rb * g.ldb + C) * 2u; }
    const size_t kstep = (size_t)(BK * 2);
    const size_t hstepA = (size_t)HALF * g.lda * 2, hstepB = (size_t)HALF * g.ldb * 2;
    const unsigned ldsw = (unsigned)wid * 1024u;
    const int aoff = lds_byte(wr * 64 + fr, fq * 8), boff = lds_byte(wc * 32 + fr, fq * 8);
#define PG8_SA(b, h) (((b) * 2 + (h)) * HTB)
#define PG8_SB(b, h) ((4 + (b) * 2 + (h)) * HTB)
#define PG8_STAGE(bufoff, gbase, voff) do { _Pragma("unroll") for (int _i = 0; _i < 2; ++_i) \
        __builtin_amdgcn_global_load_lds((const unsigned*)((const char*)(gbase) + (voff)[_i]), (LAS unsigned*)(lds + (bufoff) + ldsw + _i * 8192), 16, 0, 0); } while (0)
#define PG8_LDA(dst, b, h) do { _Pragma("unroll") for (int m = 0; m < 4; ++m) _Pragma("unroll") for (int k = 0; k < 2; ++k) dst[m][k] = *(const LAS bf16x8*)(lds + PG8_SA(b, h) + aoff + m * 2048 + k * 1024); } while (0)
#define PG8_LDB(dst, b, h) do { _Pragma("unroll") for (int n = 0; n < 2; ++n) _Pragma("unroll") for (int k = 0; k < 2; ++k) dst[n][k] = *(const LAS bf16x8*)(lds + PG8_SB(b, h) + boff + n * 2048 + k * 1024); } while (0)
#define PG8_MMA(ai, bj, At, Bt) do { __builtin_amdgcn_s_setprio(1); _Pragma("unroll") for (int m = 0; m < 4; ++m) _Pragma("unroll") for (int n = 0; n < 2; ++n) _Pragma("unroll") for (int k = 0; k < 2; ++k) \
        acc[ai][bj][m][n] = __builtin_amdgcn_mfma_f32_16x16x32_bf16(Bt[n][k], At[m][k], acc[ai][bj][m][n], 0, 0, 0); __builtin_amdgcn_s_setprio(0); } while (0)
    Unit cur, nxt; int ui = 0;
    if (!S.next(0, cur)) return;
    f32x4 acc[2][2][4][2];
#pragma unroll
    for (int a = 0; a < 2; ++a)
#pragma unroll
        for (int b = 0; b < 2; ++b)
#pragma unroll
            for (int m = 0; m < 4; ++m)
#pragma unroll
                for (int n = 0; n < 2; ++n) acc[a][b][m][n] = (f32x4){0.f, 0.f, 0.f, 0.f};
    bf16x8 At[4][2], B0[2][2], B1[2][2];
    const char* cA = cur.a; const char* cB = cur.b;
    PG8_STAGE(PG8_SB(0, 0), cB, voffB); PG8_STAGE(PG8_SB(0, 1), cB + hstepB, voffB); PG8_STAGE(PG8_SA(0, 0), cA, voffA); PG8_STAGE(PG8_SA(0, 1), cA + hstepA, voffA);
    if (wr == 1) PG8_BAR;
    PG8_WAIT_V(2); PG8_BAR;
    PG8_STAGE(PG8_SB(1, 0), cB + kstep, voffB); PG8_STAGE(PG8_SA(1, 0), cA + kstep, voffA); PG8_STAGE(PG8_SB(1, 1), cB + hstepB + kstep, voffB);
    PG8_WAIT_V(6); PG8_BAR;
    for (;;) {
        const bool has_next = S.next(ui + 1, nxt);
        const char* nA = has_next ? nxt.a : cA; const char* nB = has_next ? nxt.b : cB;
        for (int t = 0; t < nt; t += 2) {
            const bool last = (t == nt - 2);
            const char* a1 = cA + (size_t)(t + 1) * kstep;
            const char* a2 = last ? nA : cA + (size_t)(t + 2) * kstep; const char* b2 = last ? nB : cB + (size_t)(t + 2) * kstep;
            const char* a3 = a2 + kstep; const char* b3 = b2 + kstep;
            PG8_LDB(B0, 0, 0); PG8_LDB(B1, 0, 1); PG8_SCHED; PG8_LDA(At, 0, 0); PG8_STAGE(PG8_SA(1, 1), a1 + hstepA, voffA);
            PG8_WAIT_V(8); PG8_WAIT_L(0); PG8_BAR; PG8_MMA(0, 0, At, B0); PG8_MMA(0, 1, At, B1); PG8_BAR; PG8_SCHED;
            PG8_LDA(At, 0, 1); PG8_STAGE(PG8_SB(0, 0), b2, voffB); PG8_STAGE(PG8_SB(0, 1), b2 + hstepB, voffB); PG8_STAGE(PG8_SA(0, 0), a2, voffA);
            PG8_WAIT_V(8); PG8_WAIT_L(0); PG8_BAR; PG8_MMA(1, 0, At, B0); PG8_MMA(1, 1, At, B1); PG8_BAR; PG8_SCHED;
            PG8_LDB(B0, 1, 0); PG8_LDB(B1, 1, 1); PG8_SCHED; PG8_LDA(At, 1, 0); PG8_STAGE(PG8_SA(0, 1), a2 + hstepA, voffA);
            PG8_WAIT_V(8); PG8_WAIT_L(0); PG8_BAR; PG8_MMA(0, 0, At, B0); PG8_MMA(0, 1, At, B1); PG8_BAR; PG8_SCHED;
            PG8_LDA(At, 1, 1); PG8_STAGE(PG8_SB(1, 0), b3, voffB); PG8_STAGE(PG8_SB(1, 1), b3 + hstepB, voffB); PG8_STAGE(PG8_SA(1, 0), a3, voffA);
            PG8_WAIT_V(8); PG8_WAIT_L(0); PG8_BAR; PG8_MMA(1, 0, At, B0); PG8_MMA(1, 1, At, B1); PG8_BAR; PG8_SCHED;
        }
        if (wr == 0) PG8_BAR;
        { int fr_ = fr, fq_ = fq; asm volatile("" : "+v"(fr_), "+v"(fq_));
          E(acc, cur, wr, wc, fr_, fq_); }
        if (!has_next) break;
#pragma unroll
        for (int a = 0; a < 2; ++a)
#pragma unroll
            for (int b = 0; b < 2; ++b)
#pragma unroll
                for (int m = 0; m < 4; ++m)
#pragma unroll
                    for (int n = 0; n < 2; ++n) acc[a][b][m][n] = (f32x4){0.f, 0.f, 0.f, 0.f};
        cur = nxt; cA = nA; cB = nB; ++ui;
        if (wr == 1) PG8_BAR;
    }
    PG8_WAIT_V(0);
    PG8_BAR;
#undef PG8_SA
#undef PG8_SB
#undef PG8_STAGE
#undef PG8_LDA
#undef PG8_LDB
#undef PG8_MMA
}
}

typedef const f32x4 (&AccRef)[2][2][4][2];
DI u32x4 pack8(f32x4 v0, f32x4 v1) { u32x4 w; w.x = cvt_pk_bf16(v0[0], v0[1]); w.y = cvt_pk_bf16(v0[2], v0[3]); w.z = cvt_pk_bf16(v1[0], v1[1]); w.w = cvt_pk_bf16(v1[2], v1[3]); return w; }
DI u32x4 pack8h(f32x4 v0, f32x4 v1) { u32x4 w; w.x = pk2h(v0[0], v0[1]); w.y = pk2h(v0[2], v0[3]); w.z = pk2h(v1[0], v1[1]); w.w = pk2h(v1[2], v1[3]); return w; }

struct EpiBf16Split {
    static constexpr bool PERM = true;
    bf16_t* O0; int ld0; bf16_t* O1; int ld1; int split;
    DI void operator()(AccRef acc, const pg8::Unit& u, int wr, int wc, int fr, int fq) const {
        const int row0 = u.pm * 256 + wr * 64 + fr;
        bf16_t* base; int ld, colt;
        if (u.pn < split) { base = O0; ld = ld0; colt = u.pn * 256; } else { base = O1; ld = ld1; colt = (u.pn - split) * 256; }
        const int col0 = colt + wc * 32 + 8 * fq;
#pragma unroll
        for (int ai = 0; ai < 2; ++ai)
#pragma unroll
            for (int m = 0; m < 4; ++m) { bf16_t* rowp = base + (size_t)(row0 + ai * 128 + m * 16) * ld + col0;
#pragma unroll
                for (int bj = 0; bj < 2; ++bj) *(u32x4*)(rowp + bj * 128) = pack8(acc[ai][bj][m][0], acc[ai][bj][m][1]); }
    }
};

struct EpiResF32 {
    static constexpr bool PERM = false;
    float* out; int ldc; float alpha;
    DI void operator()(AccRef acc, const pg8::Unit& u, int wr, int wc, int fr, int fq) const {
        const int row0 = u.pm * 256 + wr * 64 + fr, col0 = u.pn * 256 + wc * 32 + 4 * fq;
#pragma unroll
        for (int ai = 0; ai < 2; ++ai)
#pragma unroll
            for (int m = 0; m < 4; ++m) { float* rowp = out + (size_t)(row0 + ai * 128 + m * 16) * ldc + col0;
#pragma unroll
                for (int bj = 0; bj < 2; ++bj)
#pragma unroll
                    for (int n = 0; n < 2; ++n) { f32x4* p = (f32x4*)(rowp + bj * 128 + n * 16); const f32x4 x = *p; *p = x * alpha + acc[ai][bj][m][n]; }
                asm volatile("" ::: "memory"); }
    }
};

struct EpiLora {
    static constexpr bool PERM = true;
    unsigned short* ewa; unsigned short* gate; const float* w0; const float* a0;
    DI void operator()(AccRef acc, const pg8::Unit& u, int wr, int wc, int fr, int fq) const {
        const int type = u.pn >> 2, cbase = (u.pn & 3) * 256 + wc * 32 + 8 * fq;
        const int row0 = u.pm * 256 + wr * 64 + fr;
        unsigned short* base = (type < 4) ? ewa + (size_t)type * T * A_W : gate;
        const float* bias = (type < 2) ? w0 + type * A_W : a0 + ((type - 2) & 1) * A_W;
#pragma unroll
        for (int bj = 0; bj < 2; ++bj) {
            const int cc = cbase + bj * 128;
            f32x4 b0 = (f32x4){0.f, 0.f, 0.f, 0.f}, b1 = b0;
            if (type < 4) { b0 = *(const f32x4*)(bias + cc); b1 = *(const f32x4*)(bias + cc + 4); }
#pragma unroll
            for (int ai = 0; ai < 2; ++ai)
#pragma unroll
                for (int m = 0; m < 4; ++m) {
                    f32x4 v0 = acc[ai][bj][m][0] + b0, v1 = acc[ai][bj][m][1] + b1;
                    u32x4 w;
                    if (type < 2) {
#pragma unroll
                        for (int e = 0; e < 4; ++e) { { const float z = -v0[e]; const float sp = fmaxf(z, 0.f) + __logf(1.0f + __expf(-fabsf(z))); v0[e] = __expf(-sp - 0.5f); }
                                                       { const float z = -v1[e]; const float sp = fmaxf(z, 0.f) + __logf(1.0f + __expf(-fabsf(z))); v1[e] = __expf(-sp - 0.5f); } }
                        w = pack8h(v0, v1);
                    } else if (type < 4) {
#pragma unroll
                        for (int e = 0; e < 4; ++e) { v0[e] = sigmoidf_(v0[e]); v1[e] = sigmoidf_(v1[e]); }
                        w = pack8h(v0, v1);
                    } else w = pack8(v0, v1);
                    *(u32x4*)(base + (size_t)(row0 + ai * 128 + m * 16) * A_W + cc) = w;
                    __builtin_amdgcn_sched_barrier(0);
                }
        }
    }
};

DI float l2gamma(int h) { return log1pf(-exp2f((float)(-5 - h))) * 1.4426950408889634f; }

struct EpiO1a {
    static constexpr bool PERM = true;
    bf16_t* QN; bf16_t* KN; bf16_t* GS; bf16_t* ACAT; const float* ropeN;
    DI void operator()(AccRef acc, const pg8::Unit& u, int wr, int wc, int fr, int fq) const {
        const int rbase = u.pm * 256 + wr * 64 + fr;
        if (u.pn >= 16) {
            const int col0 = (u.pn - 16) * 256 + wc * 32 + 8 * fq;
#pragma unroll
            for (int ai = 0; ai < 2; ++ai)
#pragma unroll
                for (int m = 0; m < 4; ++m) { bf16_t* rowp = GS + (size_t)(rbase + ai * 128 + m * 16) * C_V + col0;
#pragma unroll
                    for (int bj = 0; bj < 2; ++bj) { f32x4 v0 = acc[ai][bj][m][0], v1 = acc[ai][bj][m][1];
#pragma unroll
                        for (int e = 0; e < 4; ++e) { v0[e] = v0[e] * sigmoidf_(v0[e]); v1[e] = v1[e] * sigmoidf_(v1[e]); }
                        *(u32x4*)(rowp + bj * 128) = pack8(v0, v1); } }
            return;
        }
        const bool isq = u.pn < 8; const int h = u.pn & 7;
        const int i0 = wc * 32 + 8 * fq;
        const float l2g = l2gamma(h);
        const int seq_l = u.pm >> 4, nch = u.pm & 15; const size_t item = (size_t)((seq_l * 8 + h) * 16 + nch);
        bf16_t* nat = (isq ? QN : KN);
        const float ksc = isq ? 1.0f : 0.0625f;
#pragma unroll
        for (int ai = 0; ai < 2; ++ai)
#pragma unroll
            for (int m = 0; m < 4; ++m) {
                const int r = rbase + ai * 128 + m * 16, pos = r & (SEQ - 1), p = r & 255;
                const float* cp = ropeN + (size_t)pos * 128 + i0; const float* sp = cp + (size_t)SEQ * 128;
                const f32x4 c0 = *(const f32x4*)cp, c1 = *(const f32x4*)(cp + 4), s0 = *(const f32x4*)sp, s1 = *(const f32x4*)(sp + 4);
                const f32x4 x10 = acc[ai][0][m][0], x11 = acc[ai][0][m][1], x20 = acc[ai][1][m][0], x21 = acc[ai][1][m][1];
                const f32x4 o10 = (x10 * c0 - x20 * s0) * ksc, o11 = (x11 * c1 - x21 * s1) * ksc, o20 = (x10 * s0 + x20 * c0) * ksc, o21 = (x11 * s1 + x21 * c1) * ksc;
                bf16_t* rowp = nat + (size_t)r * C_QK + h * 256 + i0;
                *(u32x4*)(rowp) = pack8(o10, o11); *(u32x4*)(rowp + 128) = pack8(o20, o21);
                if (isq) {
                    const float gf = exp2f((float)(p + 1) * l2g), gb = exp2f((float)(256 - p) * l2g);
                    bf16_t* ap = ACAT + (item * 256 + p) * CATK + i0;
                    *(u32x4*)(ap + 256) = pack8(o10 * gf, o11 * gf); *(u32x4*)(ap + 256 + 128) = pack8(o20 * gf, o21 * gf);
                    *(u32x4*)(ap + 512) = pack8(o10 * gb, o11 * gb); *(u32x4*)(ap + 512 + 128) = pack8(o20 * gb, o21 * gb);
                }
            }
    }
};

struct EpiO1b {
    static constexpr bool PERM = true;
    bf16_t* KTF; bf16_t* KTB; bf16_t* BCAT; const float* ropeT;
    DI void operator()(AccRef acc, const pg8::Unit& u, int wr, int wc, int fr, int fq) const {
        const int tc0 = u.pn * 256 + wc * 32 + 8 * fq;
        if (u.pm >= 8) {
            const int vt = u.pm - 8, h = vt >> 1, dvb = (vt & 1) * 256 + wr * 64 + fr;
            const int seq_l = u.pn >> 4, nch = u.pn & 15; const size_t item = (size_t)((seq_l * 8 + h) * 16 + nch);
            const int p0 = wc * 32 + 8 * fq;
#pragma unroll
            for (int ai = 0; ai < 2; ++ai)
#pragma unroll
                for (int m = 0; m < 4; ++m) { bf16_t* rowp = BCAT + (item * 512 + dvb + ai * 128 + m * 16) * CATK + p0;
#pragma unroll
                    for (int bj = 0; bj < 2; ++bj) *(u32x4*)(rowp + bj * 128) = pack8(acc[ai][bj][m][0], acc[ai][bj][m][1]); }
            return;
        }
        const int h = u.pm; const float l2g = l2gamma(h);
#pragma unroll
        for (int bj = 0; bj < 2; ++bj) {
            const int tc = tc0 + bj * 128, pos = tc & (SEQ - 1), p = tc & 255;
            f32x4 gf0, gf1, gb0, gb1;
#pragma unroll
            for (int e = 0; e < 4; ++e) { gf0[e] = exp2f((float)(255 - (p + e)) * l2g) * 0.0625f; gf1[e] = exp2f((float)(255 - (p + 4 + e)) * l2g) * 0.0625f;
                                           gb0[e] = exp2f((float)(p + e) * l2g) * 0.0625f; gb1[e] = exp2f((float)(p + 4 + e) * l2g) * 0.0625f; }
#pragma unroll
            for (int m = 0; m < 4; ++m) {
                const int i = wr * 64 + m * 16 + fr;
                const float* cp = ropeT + (size_t)i * SEQ + pos; const float* sp = cp + (size_t)128 * SEQ;
                const f32x4 c0 = *(const f32x4*)cp, c1 = *(const f32x4*)(cp + 4), s0 = *(const f32x4*)sp, s1 = *(const f32x4*)(sp + 4);
                const f32x4 x10 = acc[0][bj][m][0], x11 = acc[0][bj][m][1], x20 = acc[1][bj][m][0], x21 = acc[1][bj][m][1];
                const f32x4 o10 = x10 * c0 - x20 * s0, o11 = x11 * c1 - x21 * s1, o20 = x10 * s0 + x20 * c0, o21 = x11 * s1 + x21 * c1;
                const size_t r1 = (size_t)(h * 256 + i) * OG_T + tc, r2 = r1 + (size_t)128 * OG_T;
                *(u32x4*)(KTF + r1) = pack8(o10 * gf0, o11 * gf1); *(u32x4*)(KTF + r2) = pack8(o20 * gf0, o21 * gf1);
                *(u32x4*)(KTB + r1) = pack8(o10 * gb0, o11 * gb1); *(u32x4*)(KTB + r2) = pack8(o20 * gb0, o21 * gb1);
            }
        }
    }
};

struct EpiO2 {
    static constexpr bool PERM = true;
    bf16_t* ACAT;
    DI void operator()(AccRef acc, const pg8::Unit& u, int wr, int wc, int fr, int fq) const {
        const int h = (u.item >> 4) & 7; const float l2g = l2gamma(h);
        const int s0 = wc * 32 + 8 * fq;
#pragma unroll
        for (int ai = 0; ai < 2; ++ai)
#pragma unroll
            for (int m = 0; m < 4; ++m) { const int t = ai * 128 + wr * 64 + m * 16 + fr; bf16_t* rowp = ACAT + ((size_t)u.item * 256 + t) * CATK + s0;
#pragma unroll
                for (int bj = 0; bj < 2; ++bj) { f32x4 v0 = acc[ai][bj][m][0], v1 = acc[ai][bj][m][1];
#pragma unroll
                    for (int e = 0; e < 4; ++e) { const int sa = s0 + bj * 128 + e; const int d0 = t - sa, d1 = t - sa - 4;
                        v0[e] *= exp2f((float)(d0 < 0 ? -d0 : d0) * l2g); v1[e] *= exp2f((float)(d1 < 0 ? -d1 : d1) * l2g); }
                    *(u32x4*)(rowp + bj * 128) = pack8(v0, v1); }
                __builtin_amdgcn_sched_barrier(0); }
    }
};

struct EpiKV {
    static constexpr bool PERM = false;
    float* KV;
    DI void operator()(AccRef acc, const pg8::Unit& u, int wr, int wc, int fr, int fq) const {
        float* base = KV + (size_t)u.item * 512 * 256 + (size_t)(u.pm * 256 + wr * 64 + fr) * 256 + wc * 32 + 4 * fq;
#pragma unroll
        for (int ai = 0; ai < 2; ++ai)
#pragma unroll
            for (int m = 0; m < 4; ++m)
#pragma unroll
                for (int bj = 0; bj < 2; ++bj)
#pragma unroll
                    for (int n = 0; n < 2; ++n) *(f32x4*)(base + (size_t)(ai * 128 + m * 16) * 256 + bj * 128 + n * 16) = acc[ai][bj][m][n];
    }
};

struct EpiY {
    static constexpr bool PERM = false;
    float* Y;
    DI void operator()(AccRef acc, const pg8::Unit& u, int wr, int wc, int fr, int fq) const {
        const int nch = u.item & 15, h = (u.item >> 4) & 7, seq_l = u.item >> 7;
        float* base = Y + (size_t)(seq_l * SEQ + nch * 256 + wr * 64 + fr) * C_V + h * 512 + u.pn * 256 + wc * 32 + 4 * fq;
#pragma unroll
        for (int ai = 0; ai < 2; ++ai)
#pragma unroll
            for (int m = 0; m < 4; ++m)
#pragma unroll
                for (int bj = 0; bj < 2; ++bj)
#pragma unroll
                    for (int n = 0; n < 2; ++n) *(f32x4*)(base + (size_t)(ai * 128 + m * 16) * C_V + bj * 128 + n * 16) = acc[ai][bj][m][n];
    }
};

template <int MODE> struct RetOrder {
    const char* P0; const char* P1; int G, c;
    DI bool next(int i, pg8::Unit& u) const {
        constexpr int UPI = (MODE == 0) ? 1 : 2;
        const int L = i * G + c; if (L >= OG_ITEMS * UPI) return false;
        const int item = L / UPI, sub = L % UPI; u.item = item;
        const int nch = item & 15, h = (item >> 4) & 7, seq_l = item >> 7; const size_t tok0 = (size_t)seq_l * SEQ + nch * 256;
        if (MODE == 0) { u.pm = 0; u.pn = 0; u.a = P0 + (tok0 * C_QK + h * 256) * 2; u.b = P1 + (tok0 * C_QK + h * 256) * 2; }
        else if (MODE == 1) { u.pm = sub; u.pn = 0; u.a = P0 + ((size_t)item * 512 + sub * 256) * CATK * 2; u.b = P1 + ((size_t)(h * 256) * OG_T + tok0) * 2; }
        else { u.pm = 0; u.pn = sub; u.a = P0 + (size_t)item * 256 * CATK * 2; u.b = P1 + ((size_t)item * 512 + sub * 256) * CATK * 2; }
        return true;
    }
};

#define XB_TMO      128
#define XB_XCNT(j)  (256  + 64 * (j))
#define XB_XSUB(j)  (1280 + 64 * (j))
#define XB_XGEN(j)  (2304 + 64 * (j))
#define XB_TOP      3328
#define XB_TOPGEN   3392
#define XCD_BAR_WORDS 3456
#define XB_SPIN_CAP (1u << 22)
DI unsigned xb_ld(unsigned* p)              { return __hip_atomic_load(p, __ATOMIC_RELAXED, __HIP_MEMORY_SCOPE_AGENT); }
DI unsigned xb_add(unsigned* p, unsigned v) { return __hip_atomic_fetch_add(p, v, __ATOMIC_RELAXED, __HIP_MEMORY_SCOPE_AGENT); }
DI unsigned xb_xcc_id() { return (unsigned)__builtin_amdgcn_s_getreg((3 << 11) | 20) & 0xFu; }
#define XB_SPIN(cond, bar) do { unsigned _sp = 0; while (cond) { __builtin_amdgcn_s_sleep(1); \
    if ((++_sp & 255u) == 0u) { if (xb_ld(&(bar)[XB_TMO])) break; if (_sp > XB_SPIN_CAP) { atomicAdd(&(bar)[XB_TMO], 1u); break; } } } } while (0)
struct XcdBarrier { unsigned* bar; unsigned x; volatile LAS unsigned* st; };
DI XcdBarrier xcd_barrier_post(unsigned* bar, volatile LAS unsigned* st) {
    XcdBarrier b; b.bar = bar; b.x = xb_xcc_id(); b.st = st;
    if (threadIdx.x == 0) (void)xb_add(&bar[XB_XCNT(b.x)], 1u);
    return b;
}
DI void xcd_barrier_complete(unsigned* bar, unsigned x, unsigned& nloc, unsigned& nx) {
    const unsigned G = gridDim.x * gridDim.y * gridDim.z;
    unsigned sum, cnt, mine, sp = 0u;
    for (;;) {
        sum = 0u; cnt = 0u; mine = 0u;
#pragma unroll
        for (unsigned j = 0; j < 16; ++j) { const unsigned c = xb_ld(&bar[XB_XCNT(j)]); sum += c; cnt += (c > 0u) ? 1u : 0u; mine = (j == x) ? c : mine; }
        if (sum == G) break;
        __builtin_amdgcn_s_sleep(1);
        if ((++sp & 255u) == 0u) { if (xb_ld(&bar[XB_TMO])) break; if (sp > XB_SPIN_CAP) { atomicAdd(&bar[XB_TMO], 1u); break; } }
    }
    nloc = mine > 0u ? mine : 1u; nx = cnt > 0u ? cnt : 1u;
}
DI void xcd_barrier(const XcdBarrier& b) {
    asm volatile("s_waitcnt vmcnt(0)" ::: "memory");
    __syncthreads();
    if (threadIdx.x == 0) {
        unsigned* bar = opaque_ptr(b.bar);
        __builtin_amdgcn_s_waitcnt(0);
        unsigned nloc = b.st[0], nx = b.st[1];
        if (nloc == 0u) { xcd_barrier_complete(bar, b.x, nloc, nx); b.st[0] = nloc; b.st[1] = nx; }
        const unsigned old = xb_add(&bar[XB_XSUB(b.x)], 1u);
        const unsigned gen = old / nloc;
        if (old + 1u == (gen + 1u) * nloc) {
            __builtin_amdgcn_fence(__ATOMIC_RELEASE, "agent");
            asm volatile("s_waitcnt vmcnt(0)" ::: "memory");
            const unsigned og = xb_add(&bar[XB_TOP], 1u);
            const unsigned tg = og / nx;
            if (og + 1u == (tg + 1u) * nx) xb_add(&bar[XB_TOPGEN], 1u);
            else XB_SPIN(xb_ld(&bar[XB_TOPGEN]) == tg, bar);
            __builtin_amdgcn_fence(__ATOMIC_ACQUIRE, "agent");
            xb_add(&bar[XB_XGEN(b.x)], 1u);
            asm volatile("s_waitcnt vmcnt(0)" ::: "memory");
        } else {
            XB_SPIN(xb_ld(&bar[XB_XGEN(b.x)]) == gen, bar);
            __builtin_amdgcn_fence(__ATOMIC_ACQUIRE, "agent");
            asm volatile("s_waitcnt vmcnt(0)" ::: "memory");
        }
    }
    __syncthreads();
}

struct Args { const float* in[28]; float* out; unsigned char* ws; int lo, hi; };
struct Ctx {
    LAS unsigned char* lds;
    int tid, lane, wave, G, bid;
    int gw, NGW;
    size_t gt, NGT;
};

DI void sincos_acc(float ang, float& s, float& c) {
    const double a = (double)ang; const double q = __builtin_rint(a * 0.63661977236758134308); const int n = (int)q;
    const float r = (float)(a - q * 1.57079632679489661923);
    const float r2 = r * r;
    const float sp = r + r * r2 * (-1.6666654611e-1f + r2 * (8.3321608736e-3f + r2 * -1.9515295891e-4f));
    const float cp = 1.0f - 0.5f * r2 + r2 * r2 * (4.166664568298827e-2f + r2 * (-1.388731625493765e-3f + r2 * 2.443315711809948e-5f));
    switch (n & 3) { case 0: s = sp; c = cp; break; case 1: s = cp; c = -sp; break; case 2: s = -sp; c = -cp; break; default: s = -cp; c = sp; break; }
}
DI void phase_init(const Ctx& C, const Args& A) {
    const f32x4* xp = (const f32x4*)A.in[0]; const f32x4* xs = (const f32x4*)A.in[1];
    f32x4* o = (f32x4*)A.out; u32x2* xb = (u32x2*)(A.ws + WS_XB);
    const size_t n4 = (size_t)T * D / 4, np4 = (size_t)8 * SEQ * D / 4;
    for (size_t i = C.gt; i < n4; i += C.NGT) { const f32x4 v = (i < np4) ? xp[i] : xs[i - np4]; o[i] = v; u32x2 w; w.x = pk2(v[0], v[1]); w.y = pk2(v[2], v[3]); xb[i] = w; }
    float* rn = (float*)(A.ws + WS_ROPE_N); float* rt = (float*)(A.ws + WS_ROPE_T);
    for (size_t i = C.gt; i < (size_t)SEQ * 128; i += C.NGT) {
        const int pos = (int)(i >> 7), k = (int)(i & 127);
        const float inv = (float)exp2(-(double)k * (13.287712379549449 / 128.0));
        const float ang = (float)pos * inv; float s, c; sincos_acc(ang, s, c);
        rn[i] = c; rn[(size_t)SEQ * 128 + i] = s;
        rt[(size_t)k * SEQ + pos] = c; rt[(size_t)128 * SEQ + (size_t)k * SEQ + pos] = s;
    }
}

DI void xpose_item(const float* W, int ldw, int c0, int K, bf16_t* WT, int drow0, LAS float* scr, int item, int nblk, int lane) {
    const int kb = item / nblk, nb = item % nblk, k0 = 64 * kb, n0 = 32 * nb;
#pragma unroll 8
    for (int i = 0; i < 32; ++i) { const int kk = 2 * i + (lane >> 5); scr[kk * 33 + (lane & 31)] = W[(size_t)(k0 + kk) * ldw + c0 + n0 + (lane & 31)]; }
    asm volatile("s_waitcnt lgkmcnt(0)" ::: "memory");
    const int c = lane & 7;
#pragma unroll
    for (int j = 0; j < 4; ++j) { const int n = (lane >> 3) + 8 * j; const LAS float* s = scr + (8 * c) * 33 + n;
        u32x4 o; o.x = pk2(s[0 * 33], s[1 * 33]); o.y = pk2(s[2 * 33], s[3 * 33]); o.z = pk2(s[4 * 33], s[5 * 33]); o.w = pk2(s[6 * 33], s[7 * 33]);
        *(u32x4*)(WT + (size_t)(drow0 + n0 + n) * K + k0 + 8 * c) = o; }
    asm volatile("s_waitcnt lgkmcnt(0)" ::: "memory");
}
struct XJob { const float* W; int ldw, c0, ncols, K; bf16_t* WT; int drow0; };
DI bool xpose_run(const Ctx& C, const XJob& j, int& base) {
    const int nblk = j.ncols / 32, items = (j.K / 64) * nblk;
    LAS float* scr = (LAS float*)(C.lds + C.wave * 16384);
    int it = (C.gw - (base % C.NGW) + C.NGW) % C.NGW;
    for (; it < items; it += C.NGW) xpose_item(j.W, j.ldw, j.c0, j.K, j.WT, j.drow0, scr, it, nblk, C.lane);
    base += items; return true;
}
DI void phase_wprep(const Ctx& C, const Args& A, int l) {
    const int e = l >> 1; int base = 0;
    if (!(l & 1)) {
        XJob j0{A.in[2] + (size_t)e * D * AB_IN, AB_IN, 0, AB_IN, D, (bf16_t*)(A.ws + WE_IN), 0}; xpose_run(C, j0, base);
        XJob j1{A.in[15] + (size_t)e * D * D, D, 0, D, D, (bf16_t*)(A.ws + WE_OUT), 0}; xpose_run(C, j1, base);
        XJob j2{A.in[22] + (size_t)l * D * FF2, FF2, 0, FF2, D, (bf16_t*)(A.ws + WE_UP), 0}; xpose_run(C, j2, base);
        XJob j3{A.in[25] + (size_t)l * D_FF * D, D, 0, D, D_FF, (bf16_t*)(A.ws + WE_DN), 0}; xpose_run(C, j3, base);
        const float* wup = A.in[5] + (size_t)e * 2 * 64 * A_W; const float* aup = A.in[7] + (size_t)e * 2 * 64 * A_W; const float* gup = A.in[8] + (size_t)e * 128 * A_W;
        bf16_t* lt = (bf16_t*)(A.ws + WE_LORA);
        for (size_t i = C.gt; i < (size_t)LORA_N * LORA_K; i += C.NGT) {
            const int row = (int)(i >> 8), kk = (int)(i & 255), type = row >> 10, c = row & 1023; float v = 0.f;
            if (type < 2) { if (kk < 64) v = wup[((size_t)type * 64 + kk) * A_W + c]; }
            else if (type < 4) { if (kk >= 64 && kk < 128) v = aup[((size_t)(type - 2) * 64 + (kk - 64)) * A_W + c]; }
            else { if (kk >= 128) v = gup[(size_t)(kk - 128) * A_W + c]; }
            lt[i] = (bf16_t)f2bf(v);
        }
    } else {
        const float* cin = A.in[16] + (size_t)e * D * C_IN; bf16_t* ct = (bf16_t*)(A.ws + WO_IN);
        XJob q{cin, C_IN, 0, 2048, D, ct, 0}; xpose_run(C, q, base);
        XJob k{cin, C_IN, 2048, 2048, D, ct, 2048}; xpose_run(C, k, base);
        XJob g{cin, C_IN, 8192, 4096, D, ct, 4096}; xpose_run(C, g, base);
        XJob k2{cin, C_IN, 2048, 2048, D, ct, 8192}; xpose_run(C, k2, base);
        XJob v{cin, C_IN, 4096, 4096, D, ct, 10240}; xpose_run(C, v, base);
        XJob o{A.in[19] + (size_t)e * C_V * D, D, 0, D, C_V, (bf16_t*)(A.ws + WO_OUT), 0}; xpose_run(C, o, base);
        XJob j2{A.in[22] + (size_t)l * D * FF2, FF2, 0, FF2, D, (bf16_t*)(A.ws + WO_UP), 0}; xpose_run(C, j2, base);
        XJob j3{A.in[25] + (size_t)l * D_FF * D, D, 0, D, D_FF, (bf16_t*)(A.ws + WO_DN), 0}; xpose_run(C, j3, base);
    }
}

DI void phase_ln(const Ctx& C, const Args& A, int row0, int nrows, const float* g, const float* b) {
    for (int m = row0 + C.gw; m < row0 + nrows; m += C.NGW) {
        f32x4* xr = (f32x4*)(A.out + (size_t)m * D) + C.lane;
        f32x4 v[8]; float s = 0.f;
#pragma unroll
        for (int j = 0; j < 8; ++j) { v[j] = xr[64 * j]; s += (v[j][0] + v[j][1]) + (v[j][2] + v[j][3]); }
        const float mean = wave_sum(s) * (1.f / D); float s2 = 0.f;
#pragma unroll
        for (int j = 0; j < 8; ++j) { v[j] = v[j] - mean; s2 += (v[j][0] * v[j][0] + v[j][1] * v[j][1]) + (v[j][2] * v[j][2] + v[j][3] * v[j][3]); }
        const float rstd = 1.f / sqrtf(wave_sum(s2) * (1.f / D) + LN_EPS);
        u32x2* o8 = (u32x2*)((bf16_t*)(A.ws + WS_XB) + (size_t)m * D) + C.lane;
#pragma unroll
        for (int j = 0; j < 8; ++j) { const f32x4 gg = ((const f32x4*)g)[C.lane + 64 * j], bb = ((const f32x4*)b)[C.lane + 64 * j];
            const f32x4 y = v[j] * rstd * gg + bb; xr[64 * j] = y; u32x2 w; w.x = pk2(y[0], y[1]); w.y = pk2(y[2], y[3]); o8[64 * j] = w; }
    }
}

DI void phase_na(const Ctx& C, const Args& A, int e) {
    const bf16_t* HB = (const bf16_t*)(A.ws + WS_HB); bf16_t* YAB = (bf16_t*)(A.ws + WS_YAB);
    const float* rpb = A.in[14] + (size_t)e * 16 * 15 * 31;
    for (int task = C.gw; task < NSEQ * 16 * 64; task += C.NGW) {
        const int r = task & 63, h = (task >> 6) & 15, sq = task >> 10;
        const int c = C.lane;
        const int rs = min(max(r - 4, 0), 56), cs = min(max(c - 8, 0), 48);
        const size_t tq = (size_t)sq * SEQ + r * 64 + c;
        float q[64], o[64];
        { const u32x4* qp = (const u32x4*)(HB + tq * NB_COLS + h * 64);
#pragma unroll
          for (int j = 0; j < 8; ++j) { const u32x4 w = qp[j]; q[8 * j + 0] = bflo(w.x) * 0.125f; q[8 * j + 1] = bfhi(w.x) * 0.125f; q[8 * j + 2] = bflo(w.y) * 0.125f; q[8 * j + 3] = bfhi(w.y) * 0.125f;
              q[8 * j + 4] = bflo(w.z) * 0.125f; q[8 * j + 5] = bfhi(w.z) * 0.125f; q[8 * j + 6] = bflo(w.w) * 0.125f; q[8 * j + 7] = bfhi(w.w) * 0.125f; } }
#pragma unroll
        for (int j = 0; j < 64; ++j) o[j] = 0.f;
        float mx = -1e30f, l = 0.f;
        for (int i = 0; i < 8; ++i) {
            const float* brow = rpb + ((size_t)h * 15 + (rs + i - r + 7)) * 31 + (cs - c + 15);
            for (int jj = 0; jj < 16; ++jj) {
                const size_t tk = (size_t)sq * SEQ + (rs + i) * 64 + cs + jj;
                const u32x4* kp = (const u32x4*)(HB + tk * NB_COLS + 1024 + h * 64);
                float s = 0.f;
#pragma unroll
                for (int j = 0; j < 8; ++j) { const u32x4 w = kp[j];
                    s += q[8 * j + 0] * bflo(w.x) + q[8 * j + 1] * bfhi(w.x) + q[8 * j + 2] * bflo(w.y) + q[8 * j + 3] * bfhi(w.y) + q[8 * j + 4] * bflo(w.z) + q[8 * j + 5] * bfhi(w.z) + q[8 * j + 6] * bflo(w.w) + q[8 * j + 7] * bfhi(w.w); }
                s += brow[jj];
                const float mn = fmaxf(mx, s), sc = __expf(mx - mn), p = __expf(s - mn);
                l = l * sc + p; mx = mn;
                const u32x4* vp = (const u32x4*)(HB + tk * NB_COLS + 2048 + h * 64);
#pragma unroll
                for (int j = 0; j < 8; ++j) { const u32x4 w = vp[j];
                    o[8 * j + 0] = o[8 * j + 0] * sc + p * bflo(w.x); o[8 * j + 1] = o[8 * j + 1] * sc + p * bfhi(w.x); o[8 * j + 2] = o[8 * j + 2] * sc + p * bflo(w.y); o[8 * j + 3] = o[8 * j + 3] * sc + p * bfhi(w.y);
                    o[8 * j + 4] = o[8 * j + 4] * sc + p * bflo(w.z); o[8 * j + 5] = o[8 * j + 5] * sc + p * bfhi(w.z); o[8 * j + 6] = o[8 * j + 6] * sc + p * bflo(w.w); o[8 * j + 7] = o[8 * j + 7] * sc + p * bfhi(w.w); }
            }
        }
        const float il = 1.0f / l;
        u32x4* op = (u32x4*)(YAB + tq * D + 1024 + h * 64);
#pragma unroll
        for (int j = 0; j < 8; ++j) { u32x4 w; w.x = pk2(o[8 * j] * il, o[8 * j + 1] * il); w.y = pk2(o[8 * j + 2] * il, o[8 * j + 3] * il); w.z = pk2(o[8 * j + 4] * il, o[8 * j + 5] * il); w.w = pk2(o[8 * j + 6] * il, o[8 * j + 7] * il); op[j] = w; }
    }
}

DI void unpack8(const u32x4 w, float (&f)[8]) { f[0] = bflo(w.x); f[1] = bfhi(w.x); f[2] = bflo(w.y); f[3] = bfhi(w.y); f[4] = bflo(w.z); f[5] = bfhi(w.z); f[6] = bflo(w.w); f[7] = bfhi(w.w); }
DI void phase_conv_a(const Ctx& C, const Args& A, int e) {
    const bf16_t* HA = (const bf16_t*)(A.ws + WS_HA); bf16_t* RK = (bf16_t*)(A.ws + WS_HB); bf16_t* LIN = (bf16_t*)(A.ws + WS_LIN);
    const float* sh = A.in[3] + (size_t)e * 3 * A_COLS;
    constexpr int C8 = A_COLS / 8;
    for (size_t i = C.gt; i < (size_t)T * C8; i += C.NGT) {
        const int t = (int)(i / C8), c8 = (int)(i % C8), c = c8 * 8, pos = t & (SEQ - 1);
        float x0[8], x1[8], x2[8];
        const u32x4 z = (u32x4){0u, 0u, 0u, 0u};
        unpack8(pos > 0 ? *(const u32x4*)(HA + (size_t)(t - 1) * A_COLS + c) : z, x0);
        unpack8(*(const u32x4*)(HA + (size_t)t * A_COLS + c), x1);
        unpack8(pos < SEQ - 1 ? *(const u32x4*)(HA + (size_t)(t + 1) * A_COLS + c) : z, x2);
        float y[8];
#pragma unroll
        for (int j = 0; j < 8; ++j) y[j] = sh[c + j] * x0[j] + sh[A_COLS + c + j] * x1[j] + sh[2 * A_COLS + c + j] * x2[j];
        if (c < 3072) { u32x4 w; w.x = pk2(y[0], y[1]); w.y = pk2(y[2], y[3]); w.z = pk2(y[4], y[5]); w.w = pk2(y[6], y[7]); *(u32x4*)(RK + (size_t)t * NB_COLS + c) = w; }
        else { const int cc = c - 3072;
#pragma unroll
            for (int j = 0; j < 8; ++j) { if (cc < 64) y[j] = tanhf(y[j]); else if (cc >= 128) y[j] = sigmoidf_(y[j]); }
            u32x4 w; w.x = pk2(y[0], y[1]); w.y = pk2(y[2], y[3]); w.z = pk2(y[4], y[5]); w.w = pk2(y[6], y[7]); *(u32x4*)(LIN + (size_t)t * LORA_K + cc) = w; }
    }
}

DI void phase_scan(const Ctx& C, const Args& A, int e) {
    const bf16_t* RK = (const bf16_t*)(A.ws + WS_HB);
    const unsigned short* EWA = (const unsigned short*)(A.ws + WS_EWA);
    const float* k_k = A.in[9] + (size_t)e * A_W; const float* k_a = A.in[10] + (size_t)e * A_W;
    LAS float* ob = (LAS float*)(C.lds + C.wave * 16384);
    const int lane = C.lane;
    for (int task = C.bid + C.G * C.wave; task < NSEQ * 32; task += C.G * NWAVES) {
        const int sq = task >> 5, h = (task & 31) >> 1, dir = task & 1;
        const size_t tbase = (size_t)sq * SEQ;
        const float kk_c = k_k[h * 64 + lane], ka_c = k_a[h * 64 + lane];
        const unsigned short* ewp = EWA + (size_t)dir * T * A_W + h * 64 + lane;
        const unsigned short* aap = EWA + (size_t)(2 + dir) * T * A_W + h * 64 + lane;
        const bf16_t* rkp = RK + h * 64 + lane;
        bf16_t* yo = (bf16_t*)(A.ws + (dir ? WS_YBK : WS_YF)) + h * 64 + lane;
        float S[64];
#pragma unroll
        for (int j = 0; j < 64; ++j) S[j] = 0.f;
        constexpr int SB = 2;
        unsigned short cr[SB], ck[SB], cv[SB], cw[SB], ca[SB], nr[SB], nk[SB], nv[SB], nw[SB], na[SB];
#pragma unroll
        for (int s = 0; s < SB; ++s) { const int st = s; const size_t t = tbase + (dir ? (SEQ - 1 - st) : st);
            cr[s] = rkp[t * NB_COLS]; ck[s] = rkp[t * NB_COLS + 1024]; cv[s] = rkp[t * NB_COLS + 2048]; cw[s] = ewp[t * A_W]; ca[s] = aap[t * A_W]; }
        for (int b = 0; b < SEQ / SB; ++b) {
            const int bn = (b + 1 < SEQ / SB) ? b + 1 : b;
#pragma unroll
            for (int s = 0; s < SB; ++s) { const int st = bn * SB + s; const size_t t = tbase + (dir ? (SEQ - 1 - st) : st);
                nr[s] = rkp[t * NB_COLS]; nk[s] = rkp[t * NB_COLS + 1024]; nv[s] = rkp[t * NB_COLS + 2048]; nw[s] = ewp[t * A_W]; na[s] = aap[t * A_W]; }
#pragma unroll
            for (int s = 0; s < SB; ++s) {
                const float r = bf2f(cr[s]), k = bf2f(ck[s]), ew = h2f(cw[s]), a = h2f(ca[s]);
                const float kkr = k * kk_c; const float ss = wave_sum(kkr * kkr);
                const float kk = kkr / fmaxf(sqrtf(ss), 1e-12f);
                ob[(s * 5 + 0) * 64 + lane] = kk; ob[(s * 5 + 1) * 64 + lane] = __expf(-ew); ob[(s * 5 + 2) * 64 + lane] = kk * a;
                ob[(s * 5 + 3) * 64 + lane] = k * (1.0f + (a - 1.0f) * ka_c); ob[(s * 5 + 4) * 64 + lane] = r;
                ob[2560 + s * 64 + lane] = bf2f(cv[s]);
            }
#pragma unroll 1
            for (int s = 0; s < SB; ++s) {
                const int st = b * SB + s; const size_t t = tbase + (dir ? (SEQ - 1 - st) : st);
                const float v = ob[2560 + s * 64 + lane];
                const LAS f32x4* p = (const LAS f32x4*)(ob + s * 320);
                float sa0 = 0.f, sa1 = 0.f, y0 = 0.f, y1 = 0.f;
                if (dir == 0) {
#pragma unroll
                    for (int jq = 0; jq < 16; ++jq) { const f32x4 k4 = p[jq]; sa0 += S[4 * jq] * k4[0] + S[4 * jq + 2] * k4[2]; sa1 += S[4 * jq + 1] * k4[1] + S[4 * jq + 3] * k4[3];
                        if ((jq & 7) == 7) __builtin_amdgcn_sched_barrier(0); }
                    const float sa = -(sa0 + sa1);
#pragma unroll
                    for (int jq = 0; jq < 16; ++jq) { const f32x4 w4 = p[16 + jq], a4 = p[32 + jq], d4 = p[48 + jq], r4 = p[64 + jq];
#pragma unroll
                        for (int q = 0; q < 4; ++q) { const float sn = S[4 * jq + q] * w4[q] + sa * a4[q] + v * d4[q]; S[4 * jq + q] = sn; if (q & 1) y1 += sn * r4[q]; else y0 += sn * r4[q]; }
                        if ((jq & 3) == 3) __builtin_amdgcn_sched_barrier(0); }
                } else {
#pragma unroll
                    for (int jq = 0; jq < 16; ++jq) { const f32x4 k4 = p[jq], r4 = p[64 + jq];
                        sa0 += S[4 * jq] * k4[0] + S[4 * jq + 2] * k4[2]; sa1 += S[4 * jq + 1] * k4[1] + S[4 * jq + 3] * k4[3];
                        y0 += S[4 * jq] * r4[0] + S[4 * jq + 2] * r4[2]; y1 += S[4 * jq + 1] * r4[1] + S[4 * jq + 3] * r4[3];
                        if ((jq & 3) == 3) __builtin_amdgcn_sched_barrier(0); }
                    const float sa = -(sa0 + sa1);
#pragma unroll
                    for (int jq = 0; jq < 16; ++jq) { const f32x4 w4 = p[16 + jq], a4 = p[32 + jq], d4 = p[48 + jq];
#pragma unroll
                        for (int q = 0; q < 4; ++q) S[4 * jq + q] = S[4 * jq + q] * w4[q] + sa * a4[q] + v * d4[q];
                        if ((jq & 3) == 3) __builtin_amdgcn_sched_barrier(0); }
                }
                yo[t * A_W] = (bf16_t)f2bf(y0 + y1);
            }
#pragma unroll
            for (int s = 0; s < SB; ++s) { cr[s] = nr[s]; ck[s] = nk[s]; cv[s] = nv[s]; cw[s] = nw[s]; ca[s] = na[s]; }
        }
    }
}

DI void phase_rwkv_post(const Ctx& C, const Args& A, int e) {
    const bf16_t* RK = (const bf16_t*)(A.ws + WS_HB); const unsigned short* AF = (const unsigned short*)(A.ws + WS_EWA) + (size_t)2 * T * A_W;
    const bf16_t* YF = (const bf16_t*)(A.ws + WS_YF); const bf16_t* YB = (const bf16_t*)(A.ws + WS_YBK); const bf16_t* GT = (const bf16_t*)(A.ws + WS_GATE);
    bf16_t* YAB = (bf16_t*)(A.ws + WS_YAB);
    const float* k_a = A.in[10] + (size_t)e * A_W; const float* r_k = A.in[11] + (size_t)e * A_W; const float* gg = A.in[12] + (size_t)e * A_W; const float* gb = A.in[13] + (size_t)e * A_W;
    for (int task = C.gw; task < T * 16; task += C.NGW) {
        const int t = task >> 4, h = task & 15, c = h * 64 + C.lane;
        const float y = bf2f(YF[(size_t)t * A_W + c]) + bf2f(YB[(size_t)t * A_W + c]);
        const float mu = wave_sum(y) * (1.f / 64.f); const float d = y - mu; const float var = wave_sum(d * d) * (1.f / 64.f);
        const float yn = d * (1.0f / sqrtf(var + A_GN_EPS)) * gg[c] + gb[c];
        const float r = bf2f(RK[(size_t)t * NB_COLS + c]), k = bf2f(RK[(size_t)t * NB_COLS + 1024 + c]), v = bf2f(RK[(size_t)t * NB_COLS + 2048 + c]);
        const float a = h2f(AF[(size_t)t * A_W + c]);
        const float kf = k * (1.0f + (a - 1.0f) * k_a[c]);
        const float bs = wave_sum(r * kf * r_k[c]);
        const float o = (yn + bs * v) * bf2f(GT[(size_t)t * A_W + c]);
        YAB[(size_t)t * D + c] = (bf16_t)f2bf(o);
    }
}

DI void phase_ffn_act(const Ctx& C, const Args& A, int l) {
    const bf16_t* H = (const bf16_t*)(A.ws + WS_HFF); bf16_t* ACT = (bf16_t*)(A.ws + WS_ACT);
    const float* cw = A.in[23] + (size_t)l * 3 * D_FF; const float* cb = A.in[24] + (size_t)l * D_FF;
    constexpr int C8 = D_FF / 8;
    for (size_t i = C.gt; i < (size_t)FG_T * C8; i += C.NGT) {
        const int t = (int)(i / C8), c = (int)(i % C8) * 8, pos = t & (SEQ - 1);
        float x0[8], x1[8], x2[8], up[8];
        const u32x4 z = (u32x4){0u, 0u, 0u, 0u};
        unpack8(pos > 0 ? *(const u32x4*)(H + (size_t)(t - 1) * FF2 + c) : z, x0);
        unpack8(*(const u32x4*)(H + (size_t)t * FF2 + c), x1);
        unpack8(pos < SEQ - 1 ? *(const u32x4*)(H + (size_t)(t + 1) * FF2 + c) : z, x2);
        unpack8(*(const u32x4*)(H + (size_t)t * FF2 + D_FF + c), up);
        float y[8];
#pragma unroll
        for (int j = 0; j < 8; ++j) { const float g = cw[c + j] * x0[j] + cw[D_FF + c + j] * x1[j] + cw[2 * D_FF + c + j] * x2[j] + cb[c + j];
            y[j] = 0.5f * g * (1.0f + erff(g * 0.70710678118654752f)) * up[j]; }
        u32x4 w; w.x = pk2(y[0], y[1]); w.y = pk2(y[2], y[3]); w.z = pk2(y[4], y[5]); w.w = pk2(y[6], y[7]);
        *(u32x4*)(ACT + (size_t)t * D_FF + c) = w;
    }
}

DI void phase_ret_scan(const Ctx& C, const Args& A) {
    const float* KVF = (const float*)(A.ws + WS_KVF); const float* KVB = (const float*)(A.ws + WS_KVB); bf16_t* BC = (bf16_t*)(A.ws + WS_BCAT);
    constexpr size_t PER = (size_t)512 * 256 / 4;
    for (size_t i = C.gt; i < (size_t)OG_SEQ * 8 * PER; i += C.NGT) {
        const int sh = (int)(i / PER), h = sh & 7; const size_t rem = i % PER; const int dv = (int)(rem >> 6), dk = (int)(rem & 63) * 4;
        const float gC = exp2f(256.0f * l2gamma(h));
        f32x4 f = (f32x4){0.f, 0.f, 0.f, 0.f};
        for (int n = 0; n < 16; ++n) { const size_t item = (size_t)sh * 16 + n;
            u32x2 w; w.x = pk2(f[0], f[1]); w.y = pk2(f[2], f[3]); *(u32x2*)(BC + (item * 512 + dv) * CATK + 256 + dk) = w;
            f = f * gC + *(const f32x4*)(KVF + (item * 512 + dv) * 256 + dk); }
        f = (f32x4){0.f, 0.f, 0.f, 0.f};
        for (int n = 15; n >= 0; --n) { const size_t item = (size_t)sh * 16 + n;
            u32x2 w; w.x = pk2(f[0], f[1]); w.y = pk2(f[2], f[3]); *(u32x2*)(BC + (item * 512 + dv) * CATK + 512 + dk) = w;
            f = f * gC + *(const f32x4*)(KVB + (item * 512 + dv) * 256 + dk); }
    }
}

DI void phase_ret_post(const Ctx& C, const Args& A, int e) {
    const float* Y = (const float*)(A.ws + WS_Y); const bf16_t* GS = (const bf16_t*)(A.ws + WS_GS); bf16_t* OB = (bf16_t*)(A.ws + WS_OB);
    const float* gg = A.in[17] + (size_t)e * C_V; const float* gb = A.in[18] + (size_t)e * C_V;
    for (int task = C.gw; task < OG_T * 8; task += C.NGW) {
        const int t = task >> 3, h = task & 7; const size_t off = (size_t)t * C_V + h * 512 + C.lane * 8;
        const f32x4 a = *(const f32x4*)(Y + off), b = *(const f32x4*)(Y + off + 4);
        const float mu = wave_sum((a[0] + a[1]) + (a[2] + a[3]) + (b[0] + b[1]) + (b[2] + b[3])) * (1.f / 512.f);
        const f32x4 da = a - mu, db = b - mu;
        const float var = wave_sum((da[0] * da[0] + da[1] * da[1]) + (da[2] * da[2] + da[3] * da[3]) + (db[0] * db[0] + db[1] * db[1]) + (db[2] * db[2] + db[3] * db[3])) * (1.f / 512.f);
        const float rs = 1.0f / sqrtf(var + LN_EPS);
        const int cc = h * 512 + C.lane * 8;
        const f32x4 g0 = *(const f32x4*)(gg + cc), g1 = *(const f32x4*)(gg + cc + 4), b0 = *(const f32x4*)(gb + cc), b1 = *(const f32x4*)(gb + cc + 4);
        float gs[8]; unpack8(*(const u32x4*)(GS + off), gs);
        const f32x4 o0 = (da * rs * g0 + b0), o1 = (db * rs * g1 + b1);
        u32x4 w; w.x = pk2(o0[0] * gs[0], o0[1] * gs[1]); w.y = pk2(o0[2] * gs[2], o0[3] * gs[3]); w.z = pk2(o1[0] * gs[4], o1[1] * gs[5]); w.w = pk2(o1[2] * gs[6], o1[3] * gs[7]);
        *(u32x4*)(OB + off) = w;
    }
}

DI bool step_ctx(Ctx& C, const Ctx& B) {
    int bid = B.bid, G = B.G, tid = B.tid;
    asm volatile("" : "+s"(bid), "+s"(G), "+v"(tid));
    C.lds = B.lds; C.tid = tid; C.lane = tid & 63; C.wave = __builtin_amdgcn_readfirstlane(tid >> 6); C.G = G; C.bid = bid;
    C.gw = bid * NWAVES + C.wave; C.NGW = G * NWAVES; C.gt = (size_t)bid * (NWAVES * 64) + tid; C.NGT = (size_t)G * NWAVES * 64;
    return true;
}
constexpr int N_STEPS = 1 + 2 * (1 + 8 + 4 * FG_N) + 2 * (1 + 7 * OG_N + 4 * FG_N);
__global__ void __launch_bounds__(NWAVES * 64, 2) mk_fwd(Args args) {
    extern __shared__ __attribute__((aligned(16))) unsigned char lds_raw[];
    Ctx C;
    C.lds = (LAS unsigned char*)lds_raw;
    C.tid = threadIdx.x; C.lane = C.tid & 63; C.wave = __builtin_amdgcn_readfirstlane(C.tid >> 6);
    C.G = gridDim.x; C.bid = blockIdx.x;
    C.gw = C.bid * NWAVES + C.wave; C.NGW = C.G * NWAVES;
    C.gt = (size_t)C.bid * (NWAVES * 64) + C.tid; C.NGT = (size_t)C.G * NWAVES * 64;
    volatile LAS unsigned* MISC = (volatile LAS unsigned*)(C.lds + MISC_OFF);
    for (int u = C.tid; u < (LDS_BYTES - LDSCTL_OFF) / 4; u += NWAVES * 64) ((LAS unsigned*)(C.lds + LDSCTL_OFF))[u] = 0u;
    __syncthreads();
    const int lo = args.lo, hi = args.hi;
    unsigned* barw = (unsigned*)(args.ws + WS_CTL) + CW_BAR;
    XcdBarrier bar; bar.bar = barw; bar.x = 0; bar.st = MISC + 8;
    if (hi - lo > 1) bar = xcd_barrier_post(barw, MISC + 8);
    LAS unsigned char* ring = C.lds;
    const Ctx Cb = C;
    int step = 0;
#define STEP_IF if (unsigned char* ws = (step >= lo && step < hi) ? opaque_ptr(args.ws) : nullptr) if (step_ctx(C, Cb))
#define STEP_END do { if (step >= lo && step + 1 < hi) xcd_barrier(bar); ++step; } while (0)

    STEP_IF { phase_init(C, args); } STEP_END;
    for (int l = 0; l < DEPTH; ++l) {
        const int e = l >> 1;
        STEP_IF { phase_wprep(C, args, l); } STEP_END;
        if (!(l & 1)) {
            STEP_IF {
                pg8::FlatOrder S; S.init(ws + WS_XB, ws + WE_IN, D, D, T, AB_IN, C.G, C.bid);
                EpiBf16Split E{(bf16_t*)(ws + WS_HA), A_COLS, (bf16_t*)(ws + WS_HB), NB_COLS, A_COLS / 256};
                pg8::gemm_phase(ring, pg8::Gemm{D, D, D}, S, E, C.tid);
            } STEP_END;
            STEP_IF { phase_na(C, args, e); } STEP_END;
            STEP_IF { phase_conv_a(C, args, e); } STEP_END;
            STEP_IF {
                pg8::FlatOrder S; S.init(ws + WS_LIN, ws + WE_LORA, LORA_K, LORA_K, T, LORA_N, C.G, C.bid);
                EpiLora E{(unsigned short*)(ws + WS_EWA), (unsigned short*)(ws + WS_GATE), args.in[4] + (size_t)e * 2 * A_W, args.in[6] + (size_t)e * 2 * A_W};
                pg8::gemm_phase(ring, pg8::Gemm{LORA_K, LORA_K, LORA_K}, S, E, C.tid);
            } STEP_END;
            STEP_IF { phase_scan(C, args, e); } STEP_END;
            STEP_IF { phase_rwkv_post(C, args, e); } STEP_END;
            STEP_IF {
                pg8::FlatOrder S; S.init(ws + WS_YAB, ws + WE_OUT, D, D, T, D, C.G, C.bid);
                EpiResF32 E{args.out, D, DN_ALPHA};
                pg8::gemm_phase(ring, pg8::Gemm{D, D, D}, S, E, C.tid);
            } STEP_END;
            STEP_IF { phase_ln(C, args, 0, T, args.in[20] + (size_t)l * D, args.in[21] + (size_t)l * D); } STEP_END;
        } else {
            for (int g = 0; g < OG_N; ++g) {
                const size_t row0 = (size_t)g * OG_T;
                STEP_IF {
                    { pg8::FlatOrder S; S.init(ws + WS_XB + row0 * D * 2, ws + WO_IN, D, D, OG_T, 8192, C.G, C.bid);
                      EpiO1a E{(bf16_t*)(ws + WS_QN), (bf16_t*)(ws + WS_KN), (bf16_t*)(ws + WS_GS), (bf16_t*)(ws + WS_ACAT), (const float*)(ws + WS_ROPE_N)};
                      pg8::gemm_phase(ring, pg8::Gemm{D, D, D}, S, E, C.tid); }
                    { pg8::FlatOrder S; S.init(ws + WO_IN + (size_t)8192 * D * 2, ws + WS_XB + row0 * D * 2, D, D, 6144, OG_T, C.G, C.bid);
                      EpiO1b E{(bf16_t*)(ws + WS_KTF), (bf16_t*)(ws + WS_KTB), (bf16_t*)(ws + WS_BCAT), (const float*)(ws + WS_ROPE_T)};
                      pg8::gemm_phase(ring, pg8::Gemm{D, D, D}, S, E, C.tid); }
                } STEP_END;
                STEP_IF {
                    { RetOrder<0> S{(const char*)(ws + WS_QN), (const char*)(ws + WS_KN), C.G, C.bid}; EpiO2 E{(bf16_t*)(ws + WS_ACAT)};
                      pg8::gemm_phase(ring, pg8::Gemm{C_QK, C_QK, 256}, S, E, C.tid); }
                    { RetOrder<1> S{(const char*)(ws + WS_BCAT), (const char*)(ws + WS_KTF), C.G, C.bid}; EpiKV E{(float*)(ws + WS_KVF)};
                      pg8::gemm_phase(ring, pg8::Gemm{CATK, OG_T, 256}, S, E, C.tid); }
                    { RetOrder<1> S{(const char*)(ws + WS_BCAT), (const char*)(ws + WS_KTB), C.G, C.bid}; EpiKV E{(float*)(ws + WS_KVB)};
                      pg8::gemm_phase(ring, pg8::Gemm{CATK, OG_T, 256}, S, E, C.tid); }
                } STEP_END;
                STEP_IF { phase_ret_scan(C, args); } STEP_END;
                STEP_IF { RetOrder<2> S{(const char*)(ws + WS_ACAT), (const char*)(ws + WS_BCAT), C.G, C.bid}; EpiY E{(float*)(ws + WS_Y)};
                          pg8::gemm_phase(ring, pg8::Gemm{CATK, CATK, CATK}, S, E, C.tid); } STEP_END;
                STEP_IF { phase_ret_post(C, args, e); } STEP_END;
                STEP_IF { pg8::FlatOrder S; S.init(ws + WS_OB, ws + WO_OUT, C_V, C_V, OG_T, D, C.G, C.bid);
                          EpiResF32 E{args.out + row0 * D, D, DN_ALPHA};
                          pg8::gemm_phase(ring, pg8::Gemm{C_V, C_V, C_V}, S, E, C.tid); } STEP_END;
                STEP_IF { phase_ln(C, args, (int)row0, OG_T, args.in[20] + (size_t)l * D, args.in[21] + (size_t)l * D); } STEP_END;
            }
        }
        for (int g = 0; g < FG_N; ++g) {
            const size_t row0 = (size_t)g * FG_T;
            const size_t wup = (l & 1) ? WO_UP : WE_UP, wdn = (l & 1) ? WO_DN : WE_DN;
            STEP_IF { pg8::FlatOrder S; S.init(ws + WS_XB + row0 * D * 2, ws + wup, D, D, FG_T, FF2, C.G, C.bid);
                      EpiBf16Split E{(bf16_t*)(ws + WS_HFF), FF2, (bf16_t*)(ws + WS_HFF), FF2, 1 << 20};
                      pg8::gemm_phase(ring, pg8::Gemm{D, D, D}, S, E, C.tid); } STEP_END;
            STEP_IF { phase_ffn_act(C, args, l); } STEP_END;
            STEP_IF { pg8::FlatOrder S; S.init(ws + WS_ACT, ws + wdn, D_FF, D_FF, FG_T, D, C.G, C.bid);
                      EpiResF32 E{args.out + row0 * D, D, DN_ALPHA};
                      pg8::gemm_phase(ring, pg8::Gemm{D_FF, D_FF, D_FF}, S, E, C.tid); } STEP_END;
            STEP_IF { phase_ln(C, args, (int)row0, FG_T, args.in[26] + (size_t)l * D, args.in[27] + (size_t)l * D); } STEP_END;
        }
    }
#undef STEP_IF
#undef STEP_END
}

extern "C" void kernel_launch(void* const* d_in, const int* in_sizes, int n_in, void* d_out, int out_size, void* d_ws, size_t ws_size, hipStream_t stream) {
    static int grid = 0;
    if (grid == 0) {
        if (n_in != 28 || out_size != T * D || ws_size < WS_NEED) { fprintf(stderr, "kernel_launch: unexpected shapes: n_in %d out %d ws %zu (need %zu)\n", n_in, out_size, ws_size, (size_t)WS_NEED); grid = -1; return; }
        int dev = 0, cus = 0, per_cu = 0;
        if (hipGetDevice(&dev) != hipSuccess || hipDeviceGetAttribute(&cus, hipDeviceAttributeMultiprocessorCount, dev) != hipSuccess) { grid = -1; return; }
        if (hipFuncSetAttribute((const void*)mk_fwd, hipFuncAttributeMaxDynamicSharedMemorySize, LDS_BYTES) != hipSuccess) { fprintf(stderr, "kernel_launch: hipFuncSetAttribute failed\n"); grid = -1; return; }
        if (hipOccupancyMaxActiveBlocksPerMultiprocessor(&per_cu, (const void*)mk_fwd, NWAVES * 64, LDS_BYTES) != hipSuccess || per_cu < 1) fprintf(stderr, "kernel_launch: occupancy query says %d\n", per_cu);
        (void)hipGetLastError();
        grid = cus;
    }
    if (grid < 0) return;
    (void)in_sizes;
    hipMemsetAsync((char*)d_ws + WS_CTL, 0, CTL_ZERO_BYTES, stream);
    Args a{};
    for (int i = 0; i < 28; ++i) a.in[i] = (const float*)d_in[i];
    a.out = (float*)d_out; a.ws = (unsigned char*)d_ws;
#if MK_MULTI_LAUNCH
    for (int s = 0; s < N_STEPS; ++s) { a.lo = s; a.hi = s + 1; hipLaunchKernelGGL(mk_fwd, dim3(grid), dim3(NWAVES * 64), LDS_BYTES, stream, a); }
#else
    a.lo = 0; a.hi = N_STEPS;
    hipLaunchKernelGGL(mk_fwd, dim3(grid), dim3(NWAVES * 64), LDS_BYTES, stream, a);
#endif
}
```

```cpp
#include <hip/hip_runtime.h>
#include <cstdio>
#include <cstdint>

#ifndef PROBE_REP_MASK
#define PROBE_REP_MASK 0u
#endif
#ifndef MK_MULTI_LAUNCH
#define MK_MULTI_LAUNCH 0
#endif

#define GAS __attribute__((address_space(1)))
#define LAS __attribute__((address_space(3)))
typedef unsigned short bf16_t;
typedef short bf16x8 __attribute__((ext_vector_type(8)));
typedef float f32x4 __attribute__((ext_vector_type(4)));
typedef float f32x2 __attribute__((ext_vector_type(2)));
typedef unsigned u32x4 __attribute__((ext_vector_type(4)));
typedef unsigned u32x2 __attribute__((ext_vector_type(2)));
typedef GAS unsigned gu32;
#define RLX_AGENT __ATOMIC_RELAXED, __HIP_MEMORY_SCOPE_AGENT
#define DI __device__ __forceinline__

constexpr int D = 2048, SEQ = 4096, NSEQ = 12, T = NSEQ * SEQ;
constexpr int A_W = 1024, A_COLS = 3328, AB_IN = 6400, B_W = 1024, NB_COLS = 3072;
constexpr int C_QK = 2048, C_V = 4096, C_IN = 12288;
constexpr int D_FF = 5504, FF2 = 11008;
constexpr int DEPTH = 4;
constexpr float DN_ALPHA = 1.6817928305074290f;
constexpr float LN_EPS = 1e-5f, A_GN_EPS = 64e-5f;
constexpr int GRID_W = 64;
constexpr int LORA_K = 256, LORA_N = 5120;
constexpr int OG_SEQ = 2, OG_T = OG_SEQ * SEQ, OG_N = NSEQ / OG_SEQ, RC = 256, RNC = SEQ / RC, OG_ITEMS = OG_SEQ * 8 * RNC;
constexpr int CATK = 768;
constexpr int FG_SEQ = 4, FG_T = FG_SEQ * SEQ, FG_N = NSEQ / FG_SEQ;

constexpr size_t MiB = 1u << 20;
constexpr size_t WS_CTL = 0, CTL_ZERO_BYTES = 1 * MiB;
constexpr size_t WS_ROPE_N = 1 * MiB;
constexpr size_t WS_ROPE_T = 5 * MiB;
constexpr size_t WS_W = 9 * MiB;
constexpr size_t WE_IN = WS_W, WE_OUT = WE_IN + (size_t)AB_IN * D * 2, WE_UP = WE_OUT + (size_t)D * D * 2, WE_DN = WE_UP + (size_t)FF2 * D * 2, WE_LORA = WE_DN + (size_t)D * D_FF * 2, WE_END = WE_LORA + (size_t)LORA_N * LORA_K * 2;
constexpr int CIN_ROWS = 14336;
constexpr size_t WO_IN = WS_W, WO_OUT = WO_IN + (size_t)CIN_ROWS * D * 2, WO_UP = WO_OUT + (size_t)D * C_V * 2, WO_DN = WO_UP + (size_t)FF2 * D * 2, WO_END = WO_DN + (size_t)D * D_FF * 2;
constexpr size_t WS_XB = 146 * MiB;
constexpr size_t WS_POOL = 338 * MiB;
static_assert(WE_END <= WS_XB && WO_END <= WS_XB, "weights region");
constexpr size_t WS_YAB = WS_XB;
constexpr size_t WS_HA = WS_POOL;
constexpr size_t WS_HB = WS_HA + (size_t)T * A_COLS * 2;
constexpr size_t WS_EWA = WS_HB + (size_t)T * NB_COLS * 2;
constexpr size_t WS_EWA_END = WS_EWA + (size_t)4 * T * A_W * 2;
constexpr size_t WS_LIN = WS_EWA_END;
constexpr size_t WS_GATE = WS_HA;
constexpr size_t WS_YF = WS_HA + (size_t)T * A_W * 2;
constexpr size_t WS_YBK = WS_YF + (size_t)T * A_W * 2;
constexpr size_t WS_KKN = WS_LIN + (size_t)T * LORA_K * 2;
constexpr size_t WS_EVEN_END = WS_KKN + (size_t)T * 16 * 4;
constexpr size_t WS_HFF = WS_POOL;
constexpr size_t WS_ACT = WS_HFF + (size_t)FG_T * FF2 * 2;
constexpr size_t WS_FFN_END = WS_ACT + (size_t)FG_T * D_FF * 2;
constexpr size_t WS_QN = WS_POOL;
constexpr size_t WS_KN = WS_QN + (size_t)OG_T * C_QK * 2;
constexpr size_t WS_GS = WS_KN + (size_t)OG_T * C_QK * 2;
constexpr size_t WS_ACAT = WS_GS + (size_t)OG_T * C_V * 2;
constexpr size_t WS_BCAT = WS_ACAT + (size_t)OG_ITEMS * 256 * CATK * 2;
constexpr size_t WS_KTF = WS_BCAT + (size_t)OG_ITEMS * 512 * CATK * 2;
constexpr size_t WS_KTB = WS_KTF + (size_t)C_QK * OG_T * 2;
constexpr size_t WS_KVF = WS_KTB + (size_t)C_QK * OG_T * 2;
constexpr size_t WS_KVB = WS_KVF + (size_t)OG_ITEMS * 512 * 256 * 4;
constexpr size_t WS_Y = WS_KVB + (size_t)OG_ITEMS * 512 * 256 * 4;
constexpr size_t WS_OB = WS_Y + (size_t)OG_T * C_V * 4;
constexpr size_t WS_ODD_END = WS_OB + (size_t)OG_T * C_V * 2;
constexpr size_t WS_NEED = 1376 * MiB;
static_assert(WS_EVEN_END <= WS_NEED && WS_FFN_END <= WS_NEED && WS_ODD_END <= WS_NEED, "d_ws map");
constexpr int CW_TMO = 0, CW_BAR = 4096;

constexpr int RING_BYTES = 131072;
constexpr int LDSCTL_OFF = RING_BYTES, MISC_OFF = LDSCTL_OFF + 320;
constexpr int LDS_BYTES = 147456;
constexpr int NWAVES = 8;

DI unsigned f2bf(float f) { unsigned u = __builtin_bit_cast(unsigned, f); return (u + 0x7fffu + ((u >> 16) & 1u)) >> 16; }
DI unsigned pk2(float lo, float hi) { return f2bf(lo) | (f2bf(hi) << 16); }
DI float bf2f(unsigned short b) { return __builtin_bit_cast(float, ((unsigned)b) << 16); }
DI float bflo(unsigned w) { return __builtin_bit_cast(float, w << 16); }
DI float bfhi(unsigned w) { return __builtin_bit_cast(float, w & 0xffff0000u); }
DI unsigned cvt_pk_bf16(float lo, float hi) { unsigned r; asm volatile("v_cvt_pk_bf16_f32 %0, %1, %2" : "=v"(r) : "v"(lo), "v"(hi)); return r; }
DI unsigned pk2h(float lo, float hi) { typedef _Float16 h2 __attribute__((ext_vector_type(2))); h2 v; v.x = (_Float16)lo; v.y = (_Float16)hi; return __builtin_bit_cast(unsigned, v); }
DI float h2f(unsigned short h) { return (float)__builtin_bit_cast(_Float16, h); }
DI float wave_sum(float v) {
#pragma unroll
    for (int o = 1; o < 64; o <<= 1) v += __shfl_xor(v, o);
    return v;
}
template <class P> DI P* opaque_ptr(P* p) { asm volatile("" : "+s"(p)); return p; }
DI float sigmoidf_(float x) { return 1.0f / (1.0f + __expf(-x)); }

namespace pg8 {
constexpr int BM = 256, BK = 64, HALF = 128, HTB = HALF * BK * 2, STAGE_BYTES = 8 * HTB, NXCD = 8, WGM = 8;
DI int lds_byte(int r, int c) { const int st = (r >> 4) * 2 + (c >> 5), rr = r & 15, cc = c & 31, ob = rr * 64 + cc * 2; return st * 1024 + (ob ^ (((ob >> 9) & 1) << 5)); }
DI void stage_rc(int b, int& R, int& C) { const int st = b / 1024, sb = b % 1024, swz = sb ^ (((sb >> 9) & 1) << 5); R = (st >> 1) * 16 + swz / 64; C = (st & 1) * 32 + (swz % 64) / 2; }
DI int perm32(int rho) { const int n = rho >> 4, i = rho & 15; return 8 * (i >> 2) + 4 * n + (i & 3); }

struct Unit { int pm, pn, item; const char* a; const char* b; };
struct Gemm { int lda, ldb, K; };

struct FlatOrder {
    const char* A; const char* Bt; int lda, ldb; int nM, nN, nwg, G, c;
    DI void init(const void* A_, const void* Bt_, int lda_, int ldb_, int M, int N, int G_, int c_) { A = (const char*)A_; Bt = (const char*)Bt_; lda = lda_; ldb = ldb_; nM = M / BM; nN = N / BM; nwg = nM * nN; G = G_; c = c_; }
    DI bool next(int i, Unit& u) const {
        const long L = (long)i * G + c; if (L >= nwg) return false;
        int wgid = (int)L; { const int q = nwg / NXCD, r = nwg % NXCD, xcd = wgid % NXCD, off = wgid / NXCD; wgid = (xcd < r ? xcd * (q + 1) : r * (q + 1) + (xcd - r) * q) + off; }
        const int nig = WGM * nN, gid = wgid / nig, fm = gid * WGM, gsz = (nM - fm) < WGM ? (nM - fm) : WGM;
        u.pm = fm + ((wgid % nig) % gsz); u.pn = (wgid % nig) / gsz; u.item = 0;
        u.a = A + (size_t)u.pm * BM * lda * 2; u.b = Bt + (size_t)u.pn * BM * ldb * 2; return true;
    }
};

#define PG8_WAIT_V(n) asm volatile("s_waitcnt vmcnt(" #n ")" ::: "memory")
#define PG8_WAIT_L(n) asm volatile("s_waitcnt lgkmcnt(" #n ")" ::: "memory")
#define PG8_BAR __builtin_amdgcn_s_barrier()
#define PG8_SCHED __builtin_amdgcn_sched_barrier(0)

template <class Epi, class Sched>
DI void gemm_phase(LAS unsigned char* lds, const Gemm g, const Sched& S, const Epi& E, const int tid) {
    const int wid = __builtin_amdgcn_readfirstlane(tid >> 6), lane = tid & 63, wr = wid >> 2, wc = wid & 3, fr = lane & 15, fq = lane >> 4;
    int K = g.K; asm volatile("" : "+s"(K));
    const int nt = K / BK;
    unsigned voffA[2], voffB[2];
#pragma unroll
    for (int i = 0; i < 2; ++i) { int R, C; stage_rc(tid * 16 + i * 8192, R, C); const int Rb = Epi::PERM ? ((R & ~31) + perm32(R & 31)) : R;
        voffA[i] = (unsigned)(R * g.lda + C) * 2u; voffB[i] = (unsigned)(Rb * g.ldb + C) * 2u; }
    const size_t kstep = (size_t)(BK * 2);
    const size_t hstepA = (size_t)HALF * g.lda * 2, hstepB = (size_t)HALF * g.ldb * 2;
    const unsigned ldsw = (unsigned)wid * 1024u;
    const int aoff = lds_byte(wr * 64 + fr, fq * 8), boff = lds_byte(wc * 32 + fr, fq * 8);
#define PG8_SA(b, h) (((b) * 2 + (h)) * HTB)
#define PG8_SB(b, h) ((4 + (b) * 2 + (h)) * HTB)
#define PG8_STAGE(bufoff, gbase, voff) do { _Pragma("unroll") for (int _i = 0; _i < 2; ++_i) \
        __builtin_amdgcn_global_load_lds((const unsigned*)((const char*)(gbase) + (voff)[_i]), (LAS unsigned*)(lds + (bufoff) + ldsw + _i * 8192), 16, 0, 0); } while (0)
#define PG8_LDA(dst, b, h) do { _Pragma("unroll") for (int m = 0; m < 4; ++m) _Pragma("unroll") for (int k = 0; k < 2; ++k) dst[m][k] = *(const LAS bf16x8*)(lds + PG8_SA(b, h) + aoff + m * 2048 + k * 1024); } while (0)
#define PG8_LDB(dst, b, h) do { _Pragma("unroll") for (int n = 0; n < 2; ++n) _Pragma("unroll") for (int k = 0; k < 2; ++k) dst[n][k] = *(const LAS bf16x8*)(lds + PG8_SB(b, h) + boff + n * 2048 + k * 1024); } while (0)
#define PG8_MMA(ai, bj, At, Bt) do { __builtin_amdgcn_s_setprio(1); _Pragma("unroll") for (int m = 0; m < 4; ++m) _Pragma("unroll") for (int n = 0; n < 2; ++n) _Pragma("unroll") for (int k = 0; k < 2; ++k) \
        acc[ai][bj][m][n] = __builtin_amdgcn_mfma_f32_16x16x32_bf16(Bt[n][k], At[m][k], acc[ai][bj][m][n], 0, 0, 0); __builtin_amdgcn_s_setprio(0); } while (0)
    Unit cur, nxt; int ui = 0;
    if (!S.next(0, cur)) return;
    f32x4 acc[2][2][4][2];
#pragma unroll
    for (int a = 0; a < 2; ++a)
#pragma unroll
        for (int b = 0; b < 2; ++b)
#pragma unroll
            for (int m = 0; m < 4; ++m)
#pragma unroll
                for (int n = 0; n < 2; ++n) acc[a][b][m][n] = (f32x4){0.f, 0.f, 0.f, 0.f};
    bf16x8 At[4][2], B0[2][2], B1[2][2];
    const char* cA = cur.a; const char* cB = cur.b;
    PG8_STAGE(PG8_SB(0, 0), cB, voffB); PG8_STAGE(PG8_SB(0, 1), cB + hstepB, voffB); PG8_STAGE(PG8_SA(0, 0), cA, voffA); PG8_STAGE(PG8_SA(0, 1), cA + hstepA, voffA);
    if (wr == 1) PG8_BAR;
    PG8_WAIT_V(2); PG8_BAR;
    PG8_STAGE(PG8_SB(1, 0), cB + kstep, voffB); PG8_STAGE(PG8_SA(1, 0), cA + kstep, voffA); PG8_STAGE(PG8_SB(1, 1), cB + hstepB + kstep, voffB);
    PG8_WAIT_V(6); PG8_BAR;
    for (;;) {
        const bool has_next = S.next(ui + 1, nxt);
        const char* nA = has_next ? nxt.a : cA; const char* nB = has_next ? nxt.b : cB;
        for (int t = 0; t < nt; t += 2) {
            const bool last = (t == nt - 2);
            const char* a1 = cA + (size_t)(t + 1) * kstep;
            const char* a2 = last ? nA : cA + (size_t)(t + 2) * kstep; const char* b2 = last ? nB : cB + (size_t)(t + 2) * kstep;
            const char* a3 = a2 + kstep; const char* b3 = b2 + kstep;
            PG8_LDB(B0, 0, 0); PG8_LDB(B1, 0, 1); PG8_SCHED; PG8_LDA(At, 0, 0); PG8_STAGE(PG8_SA(1, 1), a1 + hstepA, voffA);
            PG8_WAIT_V(8); PG8_WAIT_L(0); PG8_BAR; PG8_MMA(0, 0, At, B0); PG8_MMA(0, 1, At, B1); PG8_BAR; PG8_SCHED;
            PG8_LDA(At, 0, 1); PG8_STAGE(PG8_SB(0, 0), b2, voffB); PG8_STAGE(PG8_SB(0, 1), b2 + hstepB, voffB); PG8_STAGE(PG8_SA(0, 0), a2, voffA);
            PG8_WAIT_V(8); PG8_WAIT_L(0); PG8_BAR; PG8_MMA(1, 0, At, B0); PG8_MMA(1, 1, At, B1); PG8_BAR; PG8_SCHED;
            PG8_LDB(B0, 1, 0); PG8_LDB(B1, 1, 1); PG8_SCHED; PG8_LDA(At, 1, 0); PG8_STAGE(PG8_SA(0, 1), a2 + hstepA, voffA);
            PG8_WAIT_V(8); PG8_WAIT_L(0); PG8_BAR; PG8_MMA(0, 0, At, B0); PG8_MMA(0, 1, At, B1); PG8_BAR; PG8_SCHED;
            PG8_LDA(At, 1, 1); PG8_STAGE(PG8_SB(1, 0), b3, voffB); PG8_STAGE(PG8_SB(1, 1), b3 + hstepB, voffB); PG8_STAGE(PG8_SA(1, 0), a3, voffA);
            PG8_WAIT_V(8); PG8_WAIT_L(0); PG8_BAR; PG8_MMA(1, 0, At, B0); PG8_MMA(1, 1, At, B1); PG8_BAR; PG8_SCHED;
        }
        if (wr == 0) PG8_BAR;
        { int fr_ = fr, fq_ = fq; asm volatile("" : "+v"(fr_), "+v"(fq_));
          E(acc, cur, wr, wc, fr_, fq_); }
        if (!has_next) break;
#pragma unroll
        for (int a = 0; a < 2; ++a)
#pragma unroll
            for (int b = 0; b < 2; ++b)
#pragma unroll
                for (int m = 0; m < 4; ++m)
#pragma unroll
                    for (int n = 0; n < 2; ++n) acc[a][b][m][n] = (f32x4){0.f, 0.f, 0.f, 0.f};
        cur = nxt; cA = nA; cB = nB; ++ui;
        if (wr == 1) PG8_BAR;
    }
    PG8_WAIT_V(0);
    PG8_BAR;
#undef PG8_SA
#undef PG8_SB
#undef PG8_STAGE
#undef PG8_LDA
#undef PG8_LDB
#undef PG8_MMA
}
}

typedef const f32x4 (&AccRef)[2][2][4][2];
DI u32x4 pack8(f32x4 v0, f32x4 v1) { u32x4 w; w.x = cvt_pk_bf16(v0[0], v0[1]); w.y = cvt_pk_bf16(v0[2], v0[3]); w.z = cvt_pk_bf16(v1[0], v1[1]); w.w = cvt_pk_bf16(v1[2], v1[3]); return w; }
DI u32x4 pack8h(f32x4 v0, f32x4 v1) { u32x4 w; w.x = pk2h(v0[0], v0[1]); w.y = pk2h(v0[2], v0[3]); w.z = pk2h(v1[0], v1[1]); w.w = pk2h(v1[2], v1[3]); return w; }

struct EpiBf16Split {
    static constexpr bool PERM = true;
    bf16_t* O0; int ld0; bf16_t* O1; int ld1; int split;
    DI void operator()(AccRef acc, const pg8::Unit& u, int wr, int wc, int fr, int fq) const {
        const int row0 = u.pm * 256 + wr * 64 + fr;
        bf16_t* base; int ld, colt;
        if (u.pn < split) { base = O0; ld = ld0; colt = u.pn * 256; } else { base = O1; ld = ld1; colt = (u.pn - split) * 256; }
        const int col0 = colt + wc * 32 + 8 * fq;
#pragma unroll
        for (int ai = 0; ai < 2; ++ai)
#pragma unroll
            for (int m = 0; m < 4; ++m) { bf16_t* rowp = base + (size_t)(row0 + ai * 128 + m * 16) * ld + col0;
#pragma unroll
                for (int bj = 0; bj < 2; ++bj) *(u32x4*)(rowp + bj * 128) = pack8(acc[ai][bj][m][0], acc[ai][bj][m][1]); }
    }
};

struct EpiResF32 {
    static constexpr bool PERM = false;
    float* out; int ldc; float alpha;
    DI void operator()(AccRef acc, const pg8::Unit& u, int wr, int wc, int fr, int fq) const {
        const int row0 = u.pm * 256 + wr * 64 + fr, col0 = u.pn * 256 + wc * 32 + 4 * fq;
#pragma unroll
        for (int ai = 0; ai < 2; ++ai)
#pragma unroll
            for (int m = 0; m < 4; ++m) { float* rowp = out + (size_t)(row0 + ai * 128 + m * 16) * ldc + col0;
#pragma unroll
                for (int bj = 0; bj < 2; ++bj)
#pragma unroll
                    for (int n = 0; n < 2; ++n) { f32x4* p = (f32x4*)(rowp + bj * 128 + n * 16); const f32x4 x = *p; *p = x * alpha + acc[ai][bj][m][n]; }
                asm volatile("" ::: "memory"); }
    }
};

struct EpiLora {
    static constexpr bool PERM = true;
    unsigned short* ewa; unsigned short* gate; const float* w0; const float* a0;
    DI void operator()(AccRef acc, const pg8::Unit& u, int wr, int wc, int fr, int fq) const {
        const int type = u.pn >> 2, cbase = (u.pn & 3) * 256 + wc * 32 + 8 * fq;
        const int row0 = u.pm * 256 + wr * 64 + fr;
        unsigned short* base = (type < 4) ? ewa + (size_t)type * T * A_W : gate;
        const float* bias = (type < 2) ? w0 + type * A_W : a0 + ((type - 2) & 1) * A_W;
#pragma unroll
        for (int bj = 0; bj < 2; ++bj) {
            const int cc = cbase + bj * 128;
            f32x4 b0 = (f32x4){0.f, 0.f, 0.f, 0.f}, b1 = b0;
            if (type < 4) { b0 = *(const f32x4*)(bias + cc); b1 = *(const f32x4*)(bias + cc + 4); }
#pragma unroll
            for (int ai = 0; ai < 2; ++ai)
#pragma unroll
                for (int m = 0; m < 4; ++m) {
                    f32x4 v0 = acc[ai][bj][m][0] + b0, v1 = acc[ai][bj][m][1] + b1;
                    u32x4 w;
                    if (type < 2) {
#pragma unroll
                        for (int e = 0; e < 4; ++e) { { const float z = -v0[e]; const float sp = fmaxf(z, 0.f) + __logf(1.0f + __expf(-fabsf(z))); v0[e] = __expf(-sp - 0.5f); }
                                                       { const float z = -v1[e]; const float sp = fmaxf(z, 0.f) + __logf(1.0f + __expf(-fabsf(z))); v1[e] = __expf(-sp - 0.5f); } }
                        w = pack8h(v0, v1);
                    } else if (type < 4) {
#pragma unroll
                        for (int e = 0; e < 4; ++e) { v0[e] = sigmoidf_(v0[e]); v1[e] = sigmoidf_(v1[e]); }
                        w = pack8h(v0, v1);
                    } else w = pack8(v0, v1);
                    *(u32x4*)(base + (size_t)(row0 + ai * 128 + m * 16) * A_W + cc) = w;
                    __builtin_amdgcn_sched_barrier(0);
                }
        }
    }
};

DI float l2gamma(int h) { return log1pf(-exp2f((float)(-5 - h))) * 1.4426950408889634f; }

struct EpiO1a {
    static constexpr bool PERM = true;
    bf16_t* QN; bf16_t* KN; bf16_t* GS; bf16_t* ACAT; const float* ropeN;
    DI void operator()(AccRef acc, const pg8::Unit& u, int wr, int wc, int fr, int fq) const {
        const int rbase = u.pm * 256 + wr * 64 + fr;
        if (u.pn >= 16) {
            const int col0 = (u.pn - 16) * 256 + wc * 32 + 8 * fq;
#pragma unroll
            for (int ai = 0; ai < 2; ++ai)
#pragma unroll
                for (int m = 0; m < 4; ++m) { bf16_t* rowp = GS + (size_t)(rbase + ai * 128 + m * 16) * C_V + col0;
#pragma unroll
                    for (int bj = 0; bj < 2; ++bj) { f32x4 v0 = acc[ai][bj][m][0], v1 = acc[ai][bj][m][1];
#pragma unroll
                        for (int e = 0; e < 4; ++e) { v0[e] = v0[e] * sigmoidf_(v0[e]); v1[e] = v1[e] * sigmoidf_(v1[e]); }
                        *(u32x4*)(rowp + bj * 128) = pack8(v0, v1); } }
            return;
        }
        const bool isq = u.pn < 8; const int h = u.pn & 7;
        const int i0 = wc * 32 + 8 * fq;
        const float l2g = l2gamma(h);
        const int seq_l = u.pm >> 4, nch = u.pm & 15; const size_t item = (size_t)((seq_l * 8 + h) * 16 + nch);
        bf16_t* nat = (isq ? QN : KN);
        const float ksc = isq ? 1.0f : 0.0625f;
#pragma unroll
        for (int ai = 0; ai < 2; ++ai)
#pragma unroll
            for (int m = 0; m < 4; ++m) {
                const int r = rbase + ai * 128 + m * 16, pos = r & (SEQ - 1), p = r & 255;
                const float* cp = ropeN + (size_t)pos * 128 + i0; const float* sp = cp + (size_t)SEQ * 128;
                const f32x4 c0 = *(const f32x4*)cp, c1 = *(const f32x4*)(cp + 4), s0 = *(const f32x4*)sp, s1 = *(const f32x4*)(sp + 4);
                const f32x4 x10 = acc[ai][0][m][0], x11 = acc[ai][0][m][1], x20 = acc[ai][1][m][0], x21 = acc[ai][1][m][1];
                const f32x4 o10 = (x10 * c0 - x20 * s0) * ksc, o11 = (x11 * c1 - x21 * s1) * ksc, o20 = (x10 * s0 + x20 * c0) * ksc, o21 = (x11 * s1 + x21 * c1) * ksc;
                bf16_t* rowp = nat + (size_t)r * C_QK + h * 256 + i0;
                *(u32x4*)(rowp) = pack8(o10, o11); *(u32x4*)(rowp + 128) = pack8(o20, o21);
                if (isq) {
                    const float gf = exp2f((float)(p + 1) * l2g), gb = exp2f((float)(256 - p) * l2g);
                    bf16_t* ap = ACAT + (item * 256 + p) * CATK + i0;
                    *(u32x4*)(ap + 256) = pack8(o10 * gf, o11 * gf); *(u32x4*)(ap + 256 + 128) = pack8(o20 * gf, o21 * gf);
                    *(u32x4*)(ap + 512) = pack8(o10 * gb, o11 * gb); *(u32x4*)(ap + 512 + 128) = pack8(o20 * gb, o21 * gb);
                }
            }
    }
};

struct EpiO1b {
    static constexpr bool PERM = true;
    bf16_t* KTF; bf16_t* KTB; bf16_t* BCAT; const float* ropeT;
    DI void operator()(AccRef acc, const pg8::Unit& u, int wr, int wc, int fr, int fq) const {
        const int tc0 = u.pn * 256 + wc * 32 + 8 * fq;
        if (u.pm >= 8) {
            const int vt = u.pm - 8, h = vt >> 1, dvb = (vt & 1) * 256 + wr * 64 + fr;
            const int seq_l = u.pn >> 4, nch = u.pn & 15; const size_t item = (size_t)((seq_l * 8 + h) * 16 + nch);
            const int p0 = wc * 32 + 8 * fq;
#pragma unroll
            for (int ai = 0; ai < 2; ++ai)
#pragma unroll
                for (int m = 0; m < 4; ++m) { bf16_t* rowp = BCAT + (item * 512 + dvb + ai * 128 + m * 16) * CATK + p0;
#pragma unroll
                    for (int bj = 0; bj < 2; ++bj) *(u32x4*)(rowp + bj * 128) = pack8(acc[ai][bj][m][0], acc[ai][bj][m][1]); }
            return;
        }
        const int h = u.pm; const float l2g = l2gamma(h);
#pragma unroll
        for (int bj = 0; bj < 2; ++bj) {
            const int tc = tc0 + bj * 128, pos = tc & (SEQ - 1), p = tc & 255;
            f32x4 gf0, gf1, gb0, gb1;
#pragma unroll
            for (int e = 0; e < 4; ++e) { gf0[e] = exp2f((float)(255 - (p + e)) * l2g) * 0.0625f; gf1[e] = exp2f((float)(255 - (p + 4 + e)) * l2g) * 0.0625f;
                                           gb0[e] = exp2f((float)(p + e) * l2g) * 0.0625f; gb1[e] = exp2f((float)(p + 4 + e) * l2g) * 0.0625f; }
#pragma unroll
            for (int m = 0; m < 4; ++m) {
                const int i = wr * 64 + m * 16 + fr;
                const float* cp = ropeT + (size_t)i * SEQ + pos; const float* sp = cp + (size_t)128 * SEQ;
                const f32x4 c0 = *(const f32x4*)cp, c1 = *(const f32x4*)(cp + 4), s0 = *(const f32x4*)sp, s1 = *(const f32x4*)(sp + 4);
                const f32x4 x10 = acc[0][bj][m][0], x11 = acc[0][bj][m][1], x20 = acc[1][bj][m][0], x21 = acc[1][bj][m][1];
                const f32x4 o10 = x10 * c0 - x20 * s0, o11 = x11 * c1 - x21 * s1, o20 = x10 * s0 + x20 * c0, o21 = x11 * s1 + x21 * c1;
                const size_t r1 = (size_t)(h * 256 + i) * OG_T + tc, r2 = r1 + (size_t)128 * OG_T;
                *(u32x4*)(KTF + r1) = pack8(o10 * gf0, o11 * gf1); *(u32x4*)(KTF + r2) = pack8(o20 * gf0, o21 * gf1);
                *(u32x4*)(KTB + r1) = pack8(o10 * gb0, o11 * gb1); *(u32x4*)(KTB + r2) = pack8(o20 * gb0, o21 * gb1);
            }
        }
    }
};

struct EpiO2 {
    static constexpr bool PERM = true;
    bf16_t* ACAT;
    DI void operator()(AccRef acc, const pg8::Unit& u, int wr, int wc, int fr, int fq) const {
        const int h = (u.item >> 4) & 7; const float l2g = l2gamma(h);
        const int s0 = wc * 32 + 8 * fq;
#pragma unroll
        for (int ai = 0; ai < 2; ++ai)
#pragma unroll
            for (int m = 0; m < 4; ++m) { const int t = ai * 128 + wr * 64 + m * 16 + fr; bf16_t* rowp = ACAT + ((size_t)u.item * 256 + t) * CATK + s0;
#pragma unroll
                for (int bj = 0; bj < 2; ++bj) { f32x4 v0 = acc[ai][bj][m][0], v1 = acc[ai][bj][m][1];
#pragma unroll
                    for (int e = 0; e < 4; ++e) { const int sa = s0 + bj * 128 + e; const int d0 = t - sa, d1 = t - sa - 4;
                        v0[e] *= exp2f((float)(d0 < 0 ? -d0 : d0) * l2g); v1[e] *= exp2f((float)(d1 < 0 ? -d1 : d1) * l2g); }
                    *(u32x4*)(rowp + bj * 128) = pack8(v0, v1); }
                __builtin_amdgcn_sched_barrier(0); }
    }
};

struct EpiKV {
    static constexpr bool PERM = false;
    float* KV;
    DI void operator()(AccRef acc, const pg8::Unit& u, int wr, int wc, int fr, int fq) const {
        float* base = KV + (size_t)u.item * 512 * 256 + (size_t)(u.pm * 256 + wr * 64 + fr) * 256 + wc * 32 + 4 * fq;
#pragma unroll
        for (int ai = 0; ai < 2; ++ai)
#pragma unroll
            for (int m = 0; m < 4; ++m)
#pragma unroll
                for (int bj = 0; bj < 2; ++bj)
#pragma unroll
                    for (int n = 0; n < 2; ++n) *(f32x4*)(base + (size_t)(ai * 128 + m * 16) * 256 + bj * 128 + n * 16) = acc[ai][bj][m][n];
    }
};

struct EpiY {
    static constexpr bool PERM = false;
    float* Y;
    DI void operator()(AccRef acc, const pg8::Unit& u, int wr, int wc, int fr, int fq) const {
        const int nch = u.item & 15, h = (u.item >> 4) & 7, seq_l = u.item >> 7;
        float* base = Y + (size_t)(seq_l * SEQ + nch * 256 + wr * 64 + fr) * C_V + h * 512 + u.pn * 256 + wc * 32 + 4 * fq;
#pragma unroll
        for (int ai = 0; ai < 2; ++ai)
#pragma unroll
            for (int m = 0; m < 4; ++m)
#pragma unroll
                for (int bj = 0; bj < 2; ++bj)
#pragma unroll
                    for (int n = 0; n < 2; ++n) *(f32x4*)(base + (size_t)(ai * 128 + m * 16) * C_V + bj * 128 + n * 16) = acc[ai][bj][m][n];
    }
};

template <int MODE> struct RetOrder {
    const char* P0; const char* P1; int G, c;
    DI bool next(int i, pg8::Unit& u) const {
        constexpr int UPI = (MODE == 0) ? 1 : 2;
        const int L = i * G + c; if (L >= OG_ITEMS * UPI) return false;
        const int item = L / UPI, sub = L % UPI; u.item = item;
        const int nch = item & 15, h = (item >> 4) & 7, seq_l = item >> 7; const size_t tok0 = (size_t)seq_l * SEQ + nch * 256;
        if (MODE == 0) { u.pm = 0; u.pn = 0; u.a = P0 + (tok0 * C_QK + h * 256) * 2; u.b = P1 + (tok0 * C_QK + h * 256) * 2; }
        else if (MODE == 1) { u.pm = sub; u.pn = 0; u.a = P0 + ((size_t)item * 512 + sub * 256) * CATK * 2; u.b = P1 + ((size_t)(h * 256) * OG_T + tok0) * 2; }
        else { u.pm = 0; u.pn = sub; u.a = P0 + (size_t)item * 256 * CATK * 2; u.b = P1 + ((size_t)item * 512 + sub * 256) * CATK * 2; }
        return true;
    }
};

#define XB_TMO      128
#define XB_XCNT(j)  (256  + 64 * (j))
#define XB_XSUB(j)  (1280 + 64 * (j))
#define XB_XGEN(j)  (2304 + 64 * (j))
#define XB_TOP      3328
#define XB_TOPGEN   3392
#define XCD_BAR_WORDS 3456
#define XB_SPIN_CAP (1u << 22)
DI unsigned xb_ld(unsigned* p)              { return __hip_atomic_load(p, __ATOMIC_RELAXED, __HIP_MEMORY_SCOPE_AGENT); }
DI unsigned xb_add(unsigned* p, unsigned v) { return __hip_atomic_fetch_add(p, v, __ATOMIC_RELAXED, __HIP_MEMORY_SCOPE_AGENT); }
DI unsigned xb_xcc_id() { return (unsigned)__builtin_amdgcn_s_getreg((3 << 11) | 20) & 0xFu; }
#define XB_SPIN(cond, bar) do { unsigned _sp = 0; while (cond) { __builtin_amdgcn_s_sleep(1); \
    if ((++_sp & 255u) == 0u) { if (xb_ld(&(bar)[XB_TMO])) break; if (_sp > XB_SPIN_CAP) { atomicAdd(&(bar)[XB_TMO], 1u); break; } } } } while (0)
struct XcdBarrier { unsigned* bar; unsigned x; volatile LAS unsigned* st; };
DI XcdBarrier xcd_barrier_post(unsigned* bar, volatile LAS unsigned* st) {
    XcdBarrier b; b.bar = bar; b.x = xb_xcc_id(); b.st = st;
    if (threadIdx.x == 0) (void)xb_add(&bar[XB_XCNT(b.x)], 1u);
    return b;
}
DI void xcd_barrier_complete(unsigned* bar, unsigned x, unsigned& nloc, unsigned& nx) {
    const unsigned G = gridDim.x * gridDim.y * gridDim.z;
    unsigned sum, cnt, mine, sp = 0u;
    for (;;) {
        sum = 0u; cnt = 0u; mine = 0u;
#pragma unroll
        for (unsigned j = 0; j < 16; ++j) { const unsigned c = xb_ld(&bar[XB_XCNT(j)]); sum += c; cnt += (c > 0u) ? 1u : 0u; mine = (j == x) ? c : mine; }
        if (sum == G) break;
        __builtin_amdgcn_s_sleep(1);
        if ((++sp & 255u) == 0u) { if (xb_ld(&bar[XB_TMO])) break; if (sp > XB_SPIN_CAP) { atomicAdd(&bar[XB_TMO], 1u); break; } }
    }
    nloc = mine > 0u ? mine : 1u; nx = cnt > 0u ? cnt : 1u;
}
DI void xcd_barrier(const XcdBarrier& b) {
    asm volatile("s_waitcnt vmcnt(0)" ::: "memory");
    __syncthreads();
    if (threadIdx.x == 0) {
        unsigned* bar = opaque_ptr(b.bar);
        __builtin_amdgcn_s_waitcnt(0);
        unsigned nloc = b.st[0], nx = b.st[1];
        if (nloc == 0u) { xcd_barrier_complete(bar, b.x, nloc, nx); b.st[0] = nloc; b.st[1] = nx; }
        const unsigned old = xb_add(&bar[XB_XSUB(b.x)], 1u);
        const unsigned gen = old / nloc;
        if (old + 1u == (gen + 1u) * nloc) {
            __builtin_amdgcn_fence(__ATOMIC_RELEASE, "agent");
            asm volatile("s_waitcnt vmcnt(0)" ::: "memory");
            const unsigned og = xb_add(&bar[XB_TOP], 1u);
            const unsigned tg = og / nx;
            if (og + 1u == (tg + 1u) * nx) xb_add(&bar[XB_TOPGEN], 1u);
            else XB_SPIN(xb_ld(&bar[XB_TOPGEN]) == tg, bar);
            __builtin_amdgcn_fence(__ATOMIC_ACQUIRE, "agent");
            xb_add(&bar[XB_XGEN(b.x)], 1u);
            asm volatile("s_waitcnt vmcnt(0)" ::: "memory");
        } else {
            XB_SPIN(xb_ld(&bar[XB_XGEN(b.x)]) == gen, bar);
            __builtin_amdgcn_fence(__ATOMIC_ACQUIRE, "agent");
            asm volatile("s_waitcnt vmcnt(0)" ::: "memory");
        }
    }
    __syncthreads();
}

struct Args { const float* in[28]; float* out; unsigned char* ws; int lo, hi; };
struct Ctx {
    LAS unsigned char* lds;
    int tid, lane, wave, G, bid;
    int gw, NGW;
    size_t gt, NGT;
};

DI void sincos_acc(float ang, float& s, float& c) {
    const double a = (double)ang; const double q = __builtin_rint(a * 0.63661977236758134308); const int n = (int)q;
    const float r = (float)(a - q * 1.57079632679489661923);
    const float r2 = r * r;
    const float sp = r + r * r2 * (-1.6666654611e-1f + r2 * (8.3321608736e-3f + r2 * -1.9515295891e-4f));
    const float cp = 1.0f - 0.5f * r2 + r2 * r2 * (4.166664568298827e-2f + r2 * (-1.388731625493765e-3f + r2 * 2.443315711809948e-5f));
    switch (n & 3) { case 0: s = sp; c = cp; break; case 1: s = cp; c = -sp; break; case 2: s = -sp; c = -cp; break; default: s = -cp; c = sp; break; }
}
DI void phase_init(const Ctx& C, const Args& A) {
    const f32x4* xp = (const f32x4*)A.in[0]; const f32x4* xs = (const f32x4*)A.in[1];
    f32x4* o = (f32x4*)A.out; u32x2* xb = (u32x2*)(A.ws + WS_XB);
    const size_t n4 = (size_t)T * D / 4, np4 = (size_t)8 * SEQ * D / 4;
    for (size_t i = C.gt; i < n4; i += C.NGT) { const f32x4 v = (i < np4) ? xp[i] : xs[i - np4]; o[i] = v; u32x2 w; w.x = pk2(v[0], v[1]); w.y = pk2(v[2], v[3]); xb[i] = w; }
    float* rn = (float*)(A.ws + WS_ROPE_N); float* rt = (float*)(A.ws + WS_ROPE_T);
    for (size_t i = C.gt; i < (size_t)SEQ * 128; i += C.NGT) {
        const int pos = (int)(i >> 7), k = (int)(i & 127);
        const float inv = (float)exp2(-(double)k * (13.287712379549449 / 128.0));
        const float ang = (float)pos * inv; float s, c; sincos_acc(ang, s, c);
        rn[i] = c; rn[(size_t)SEQ * 128 + i] = s;
        rt[(size_t)k * SEQ + pos] = c; rt[(size_t)128 * SEQ + (size_t)k * SEQ + pos] = s;
    }
}

DI void xpose_item(const float* W, int ldw, int c0, int K, bf16_t* WT, int drow0, LAS float* scr, int item, int nblk, int lane) {
    const int kb = item / nblk, nb = item % nblk, k0 = 64 * kb, n0 = 32 * nb;
#pragma unroll 8
    for (int i = 0; i < 32; ++i) { const int kk = 2 * i + (lane >> 5); scr[kk * 33 + (lane & 31)] = W[(size_t)(k0 + kk) * ldw + c0 + n0 + (lane & 31)]; }
    asm volatile("s_waitcnt lgkmcnt(0)" ::: "memory");
    const int c = lane & 7;
#pragma unroll
    for (int j = 0; j < 4; ++j) { const int n = (lane >> 3) + 8 * j; const LAS float* s = scr + (8 * c) * 33 + n;
        u32x4 o; o.x = pk2(s[0 * 33], s[1 * 33]); o.y = pk2(s[2 * 33], s[3 * 33]); o.z = pk2(s[4 * 33], s[5 * 33]); o.w = pk2(s[6 * 33], s[7 * 33]);
        *(u32x4*)(WT + (size_t)(drow0 + n0 + n) * K + k0 + 8 * c) = o; }
    asm volatile("s_waitcnt lgkmcnt(0)" ::: "memory");
}
struct XJob { const float* W; int ldw, c0, ncols, K; bf16_t* WT; int drow0; };
DI bool xpose_run(const Ctx& C, const XJob& j, int& base) {
    const int nblk = j.ncols / 32, items = (j.K / 64) * nblk;
    LAS float* scr = (LAS float*)(C.lds + C.wave * 16384);
    int it = (C.gw - (base % C.NGW) + C.NGW) % C.NGW;
    for (; it < items; it += C.NGW) xpose_item(j.W, j.ldw, j.c0, j.K, j.WT, j.drow0, scr, it, nblk, C.lane);
    base += items; return true;
}
DI void phase_wprep(const Ctx& C, const Args& A, int l) {
    const int e = l >> 1; int base = 0;
    if (!(l & 1)) {
        XJob j0{A.in[2] + (size_t)e * D * AB_IN, AB_IN, 0, AB_IN, D, (bf16_t*)(A.ws + WE_IN), 0}; xpose_run(C, j0, base);
        XJob j1{A.in[15] + (size_t)e * D * D, D, 0, D, D, (bf16_t*)(A.ws + WE_OUT), 0}; xpose_run(C, j1, base);
        XJob j2{A.in[22] + (size_t)l * D * FF2, FF2, 0, FF2, D, (bf16_t*)(A.ws + WE_UP), 0}; xpose_run(C, j2, base);
        XJob j3{A.in[25] + (size_t)l * D_FF * D, D, 0, D, D_FF, (bf16_t*)(A.ws + WE_DN), 0}; xpose_run(C, j3, base);
        const float* wup = A.in[5] + (size_t)e * 2 * 64 * A_W; const float* aup = A.in[7] + (size_t)e * 2 * 64 * A_W; const float* gup = A.in[8] + (size_t)e * 128 * A_W;
        bf16_t* lt = (bf16_t*)(A.ws + WE_LORA);
        for (size_t i = C.gt; i < (size_t)LORA_N * LORA_K; i += C.NGT) {
            const int row = (int)(i >> 8), kk = (int)(i & 255), type = row >> 10, c = row & 1023; float v = 0.f;
            if (type < 2) { if (kk < 64) v = wup[((size_t)type * 64 + kk) * A_W + c]; }
            else if (type < 4) { if (kk >= 64 && kk < 128) v = aup[((size_t)(type - 2) * 64 + (kk - 64)) * A_W + c]; }
            else { if (kk >= 128) v = gup[(size_t)(kk - 128) * A_W + c]; }
            lt[i] = (bf16_t)f2bf(v);
        }
    } else {
        const float* cin = A.in[16] + (size_t)e * D * C_IN; bf16_t* ct = (bf16_t*)(A.ws + WO_IN);
        XJob q{cin, C_IN, 0, 2048, D, ct, 0}; xpose_run(C, q, base);
        XJob k{cin, C_IN, 2048, 2048, D, ct, 2048}; xpose_run(C, k, base);
        XJob g{cin, C_IN, 8192, 4096, D, ct, 4096}; xpose_run(C, g, base);
        XJob k2{cin, C_IN, 2048, 2048, D, ct, 8192}; xpose_run(C, k2, base);
        XJob v{cin, C_IN, 4096, 4096, D, ct, 10240}; xpose_run(C, v, base);
        XJob o{A.in[19] + (size_t)e * C_V * D, D, 0, D, C_V, (bf16_t*)(A.ws + WO_OUT), 0}; xpose_run(C, o, base);
        XJob j2{A.in[22] + (size_t)l * D * FF2, FF2, 0, FF2, D, (bf16_t*)(A.ws + WO_UP), 0}; xpose_run(C, j2, base);
        XJob j3{A.in[25] + (size_t)l * D_FF * D, D, 0, D, D_FF, (bf16_t*)(A.ws + WO_DN), 0}; xpose_run(C, j3, base);
    }
}

DI void phase_ln(const Ctx& C, const Args& A, int row0, int nrows, const float* g, const float* b) {
    for (int m = row0 + C.gw; m < row0 + nrows; m += C.NGW) {
        f32x4* xr = (f32x4*)(A.out + (size_t)m * D) + C.lane;
        f32x4 v[8]; float s = 0.f;
#pragma unroll
        for (int j = 0; j < 8; ++j) { v[j] = xr[64 * j]; s += (v[j][0] + v[j][1]) + (v[j][2] + v[j][3]); }
        const float mean = wave_sum(s) * (1.f / D); float s2 = 0.f;
#pragma unroll
        for (int j = 0; j < 8; ++j) { v[j] = v[j] - mean; s2 += (v[j][0] * v[j][0] + v[j][1] * v[j][1]) + (v[j][2] * v[j][2] + v[j][3] * v[j][3]); }
        const float rstd = 1.f / sqrtf(wave_sum(s2) * (1.f / D) + LN_EPS);
        u32x2* o8 = (u32x2*)((bf16_t*)(A.ws + WS_XB) + (size_t)m * D) + C.lane;
#pragma unroll
        for (int j = 0; j < 8; ++j) { const f32x4 gg = ((const f32x4*)g)[C.lane + 64 * j], bb = ((const f32x4*)b)[C.lane + 64 * j];
            const f32x4 y = v[j] * rstd * gg + bb; xr[64 * j] = y; u32x2 w; w.x = pk2(y[0], y[1]); w.y = pk2(y[2], y[3]); o8[64 * j] = w; }
    }
}

DI void phase_na(const Ctx& C, const Args& A, int e) {
    const bf16_t* HB = (const bf16_t*)(A.ws + WS_HB); bf16_t* YAB = (bf16_t*)(A.ws + WS_YAB);
    const float* rpb = A.in[14] + (size_t)e * 16 * 15 * 31;
    for (int task = C.gw; task < NSEQ * 16 * 64; task += C.NGW) {
        const int r = task & 63, h = (task >> 6) & 15, sq = task >> 10;
        const int c = C.lane;
        const int rs = min(max(r - 4, 0), 56), cs = min(max(c - 8, 0), 48);
        const size_t tq = (size_t)sq * SEQ + r * 64 + c;
        float q[64], o[64];
        { const u32x4* qp = (const u32x4*)(HB + tq * NB_COLS + h * 64);
#pragma unroll
          for (int j = 0; j < 8; ++j) { const u32x4 w = qp[j]; q[8 * j + 0] = bflo(w.x) * 0.125f; q[8 * j + 1] = bfhi(w.x) * 0.125f; q[8 * j + 2] = bflo(w.y) * 0.125f; q[8 * j + 3] = bfhi(w.y) * 0.125f;
              q[8 * j + 4] = bflo(w.z) * 0.125f; q[8 * j + 5] = bfhi(w.z) * 0.125f; q[8 * j + 6] = bflo(w.w) * 0.125f; q[8 * j + 7] = bfhi(w.w) * 0.125f; } }
#pragma unroll
        for (int j = 0; j < 64; ++j) o[j] = 0.f;
        float mx = -1e30f, l = 0.f;
        for (int i = 0; i < 8; ++i) {
            const float* brow = rpb + ((size_t)h * 15 + (rs + i - r + 7)) * 31 + (cs - c + 15);
            for (int jj = 0; jj < 16; ++jj) {
                const size_t tk = (size_t)sq * SEQ + (rs + i) * 64 + cs + jj;
                const u32x4* kp = (const u32x4*)(HB + tk * NB_COLS + 1024 + h * 64);
                float s = 0.f;
#pragma unroll
                for (int j = 0; j < 8; ++j) { const u32x4 w = kp[j];
                    s += q[8 * j + 0] * bflo(w.x) + q[8 * j + 1] * bfhi(w.x) + q[8 * j + 2] * bflo(w.y) + q[8 * j + 3] * bfhi(w.y) + q[8 * j + 4] * bflo(w.z) + q[8 * j + 5] * bfhi(w.z) + q[8 * j + 6] * bflo(w.w) + q[8 * j + 7] * bfhi(w.w); }
                s += brow[jj];
                const float mn = fmaxf(mx, s), sc = __expf(mx - mn), p = __expf(s - mn);
                l = l * sc + p; mx = mn;
                const u32x4* vp = (const u32x4*)(HB + tk * NB_COLS + 2048 + h * 64);
#pragma unroll
                for (int j = 0; j < 8; ++j) { const u32x4 w = vp[j];
                    o[8 * j + 0] = o[8 * j + 0] * sc + p * bflo(w.x); o[8 * j + 1] = o[8 * j + 1] * sc + p * bfhi(w.x); o[8 * j + 2] = o[8 * j + 2] * sc + p * bflo(w.y); o[8 * j + 3] = o[8 * j + 3] * sc + p * bfhi(w.y);
                    o[8 * j + 4] = o[8 * j + 4] * sc + p * bflo(w.z); o[8 * j + 5] = o[8 * j + 5] * sc + p * bfhi(w.z); o[8 * j + 6] = o[8 * j + 6] * sc + p * bflo(w.w); o[8 * j + 7] = o[8 * j + 7] * sc + p * bfhi(w.w); }
            }
        }
        const float il = 1.0f / l;
        u32x4* op = (u32x4*)(YAB + tq * D + 1024 + h * 64);
#pragma unroll
        for (int j = 0; j < 8; ++j) { u32x4 w; w.x = pk2(o[8 * j] * il, o[8 * j + 1] * il); w.y = pk2(o[8 * j + 2] * il, o[8 * j + 3] * il); w.z = pk2(o[8 * j + 4] * il, o[8 * j + 5] * il); w.w = pk2(o[8 * j + 6] * il, o[8 * j + 7] * il); op[j] = w; }
    }
}

DI void unpack8(const u32x4 w, float (&f)[8]) { f[0] = bflo(w.x); f[1] = bfhi(w.x); f[2] = bflo(w.y); f[3] = bfhi(w.y); f[4] = bflo(w.z); f[5] = bfhi(w.z); f[6] = bflo(w.w); f[7] = bfhi(w.w); }
DI void phase_conv_a(const Ctx& C, const Args& A, int e) {
    const bf16_t* HA = (const bf16_t*)(A.ws + WS_HA); bf16_t* RK = (bf16_t*)(A.ws + WS_HB); bf16_t* LIN = (bf16_t*)(A.ws + WS_LIN);
    const float* sh = A.in[3] + (size_t)e * 3 * A_COLS; const float* k_k = A.in[9] + (size_t)e * A_W; float* KKN = (float*)(A.ws + WS_KKN);
    constexpr int C8 = A_COLS / 8;
    for (size_t i = C.gt; i < (size_t)T * C8; i += C.NGT) {
        const int t = (int)(i / C8), c8 = (int)(i % C8), c = c8 * 8, pos = t & (SEQ - 1);
        float x0[8], x1[8], x2[8];
        const u32x4 z = (u32x4){0u, 0u, 0u, 0u};
        unpack8(pos > 0 ? *(const u32x4*)(HA + (size_t)(t - 1) * A_COLS + c) : z, x0);
        unpack8(*(const u32x4*)(HA + (size_t)t * A_COLS + c), x1);
        unpack8(pos < SEQ - 1 ? *(const u32x4*)(HA + (size_t)(t + 1) * A_COLS + c) : z, x2);
        float y[8];
#pragma unroll
        for (int j = 0; j < 8; ++j) y[j] = sh[c + j] * x0[j] + sh[A_COLS + c + j] * x1[j] + sh[2 * A_COLS + c + j] * x2[j];
        {
            float p = 0.f;
            if (c >= 1024 && c < 2048) {
#pragma unroll
                for (int j = 0; j < 8; ++j) { const float kb = bf2f((unsigned short)f2bf(y[j])) * k_k[c - 1024 + j]; p += kb * kb; } }
            p += __shfl_xor(p, 1); p += __shfl_xor(p, 2); p += __shfl_xor(p, 4);
            if (c >= 1024 && c < 2048 && (c8 & 7) == 0) KKN[(size_t)t * 16 + ((c - 1024) >> 6)] = 1.0f / fmaxf(sqrtf(p), 1e-12f);
        }
        if (c < 3072) { u32x4 w; w.x = pk2(y[0], y[1]); w.y = pk2(y[2], y[3]); w.z = pk2(y[4], y[5]); w.w = pk2(y[6], y[7]); *(u32x4*)(RK + (size_t)t * NB_COLS + c) = w; }
        else { const int cc = c - 3072;
#pragma unroll
            for (int j = 0; j < 8; ++j) { if (cc < 64) y[j] = tanhf(y[j]); else if (cc >= 128) y[j] = sigmoidf_(y[j]); }
            u32x4 w; w.x = pk2(y[0], y[1]); w.y = pk2(y[2], y[3]); w.z = pk2(y[4], y[5]); w.w = pk2(y[6], y[7]); *(u32x4*)(LIN + (size_t)t * LORA_K + cc) = w; }
    }
}

#define DPP_FMAC(acc, bvec, x, N) asm("v_fmac_f32_dpp %0, %1, %2 row_newbcast:" #N " row_mask:0xf bank_mask:0xf" : "+v"(acc) : "v"(bvec), "v"(x))
#define DPP_MUL(dst, bvec, x, N)  asm("v_mul_f32_dpp %0, %1, %2 row_newbcast:" #N " row_mask:0xf bank_mask:0xf" : "=v"(dst) : "v"(bvec), "v"(x))
DI float xrow_sum(float x) {
    float a = x, b = x;
    asm("s_nop 1\n\tv_permlane16_swap_b32 %0, %1" : "+v"(a), "+v"(b));
    const float s = a + b; float c = s, d = s;
    asm("s_nop 1\n\tv_permlane32_swap_b32 %0, %1" : "+v"(c), "+v"(d));
    return c + d;
}
template <int DIR> DI void scan_task(const Ctx& C, const Args& A, int e, int sq, int h, int wv) {
    constexpr int PD = 8;
    const int lane = C.lane, il = lane & 15;
    const size_t tb = (size_t)sq * SEQ;
    const bf16_t* rkp = (const bf16_t*)(A.ws + WS_HB) + tb * NB_COLS + h * 64;
    const unsigned short* ewp = (const unsigned short*)(A.ws + WS_EWA) + (size_t)DIR * T * A_W + tb * A_W + h * 64 + lane;
    const unsigned short* aap = (const unsigned short*)(A.ws + WS_EWA) + (size_t)(2 + DIR) * T * A_W + tb * A_W + h * 64 + lane;
    const float* knp = (const float*)(A.ws + WS_KKN) + tb * 16 + h;
    bf16_t* yo = (bf16_t*)(A.ws + (DIR ? WS_YBK : WS_YF)) + tb * A_W + h * 64 + 16 * wv + il;
    const float kk_c = (A.in[9] + (size_t)e * A_W)[h * 64 + lane], ka_c = (A.in[10] + (size_t)e * A_W)[h * 64 + lane];
    float S[16];
#pragma unroll
    for (int n = 0; n < 16; ++n) S[n] = 0.f;
    unsigned short pr[PD], pk[PD], pv[PD], pw[PD], pa[PD]; float pn[PD];
#define SCAN_T(st) ((size_t)(DIR ? (SEQ - 1 - (st)) : (st)))
#define SCAN_LOAD(slot, st) do { const size_t t_ = SCAN_T(st); pr[slot] = rkp[t_ * NB_COLS + lane]; pk[slot] = rkp[t_ * NB_COLS + 1024 + lane]; pv[slot] = rkp[t_ * NB_COLS + 2048 + 16 * wv + il]; \
        pw[slot] = ewp[t_ * A_W]; pa[slot] = aap[t_ * A_W]; pn[slot] = knp[t_ * 16]; } while (0)
#define SCAN_OPS(slot) do { const float k_ = bf2f(pk[slot]), a_ = h2f(pa[slot]); kk = k_ * kk_c * pn[slot]; w = __expf(-h2f(pw[slot])); ka = kk * a_; kd = k_ * (1.0f + (a_ - 1.0f) * ka_c); rr = bf2f(pr[slot]); vv = bf2f(pv[slot]); } while (0)
#pragma unroll
    for (int s = 0; s < PD; ++s) SCAN_LOAD(s, s);
    float kk, w, ka, kd, rr, vv;
    SCAN_OPS(0);
    for (int b = 0; b < SEQ / PD; ++b) {
#pragma unroll
        for (int s = 0; s < PD; ++s) {
            const int st = b * PD + s;
            asm volatile("s_nop 1" : "+v"(kk), "+v"(w), "+v"(ka), "+v"(kd), "+v"(rr));
            float sa0, sa1, sa2, sa3, y0, y1, y2, y3;
            DPP_MUL(sa0, kk, S[0], 0); DPP_MUL(sa1, kk, S[1], 1); DPP_MUL(sa2, kk, S[2], 2); DPP_MUL(sa3, kk, S[3], 3);
            DPP_FMAC(sa0, kk, S[4], 4); DPP_FMAC(sa1, kk, S[5], 5); DPP_FMAC(sa2, kk, S[6], 6); DPP_FMAC(sa3, kk, S[7], 7);
            DPP_FMAC(sa0, kk, S[8], 8); DPP_FMAC(sa1, kk, S[9], 9); DPP_FMAC(sa2, kk, S[10], 10); DPP_FMAC(sa3, kk, S[11], 11);
            DPP_FMAC(sa0, kk, S[12], 12); DPP_FMAC(sa1, kk, S[13], 13); DPP_FMAC(sa2, kk, S[14], 14); DPP_FMAC(sa3, kk, S[15], 15);
            if (DIR == 1) {
                DPP_MUL(y0, rr, S[0], 0); DPP_MUL(y1, rr, S[1], 1); DPP_MUL(y2, rr, S[2], 2); DPP_MUL(y3, rr, S[3], 3);
                DPP_FMAC(y0, rr, S[4], 4); DPP_FMAC(y1, rr, S[5], 5); DPP_FMAC(y2, rr, S[6], 6); DPP_FMAC(y3, rr, S[7], 7);
                DPP_FMAC(y0, rr, S[8], 8); DPP_FMAC(y1, rr, S[9], 9); DPP_FMAC(y2, rr, S[10], 10); DPP_FMAC(y3, rr, S[11], 11);
                DPP_FMAC(y0, rr, S[12], 12); DPP_FMAC(y1, rr, S[13], 13); DPP_FMAC(y2, rr, S[14], 14); DPP_FMAC(y3, rr, S[15], 15);
            }
            const float sa = -xrow_sum((sa0 + sa1) + (sa2 + sa3));
#define SCAN_UPD(n) { float t_; DPP_MUL(t_, kd, vv, n); DPP_FMAC(t_, ka, sa, n); DPP_FMAC(t_, w, S[n], n); S[n] = t_; }
            SCAN_UPD(0) SCAN_UPD(1) SCAN_UPD(2) SCAN_UPD(3) SCAN_UPD(4) SCAN_UPD(5) SCAN_UPD(6) SCAN_UPD(7)
            SCAN_UPD(8) SCAN_UPD(9) SCAN_UPD(10) SCAN_UPD(11) SCAN_UPD(12) SCAN_UPD(13) SCAN_UPD(14) SCAN_UPD(15)
#undef SCAN_UPD
            if (DIR == 0) {
                DPP_MUL(y0, rr, S[0], 0); DPP_MUL(y1, rr, S[1], 1); DPP_MUL(y2, rr, S[2], 2); DPP_MUL(y3, rr, S[3], 3);
                DPP_FMAC(y0, rr, S[4], 4); DPP_FMAC(y1, rr, S[5], 5); DPP_FMAC(y2, rr, S[6], 6); DPP_FMAC(y3, rr, S[7], 7);
                DPP_FMAC(y0, rr, S[8], 8); DPP_FMAC(y1, rr, S[9], 9); DPP_FMAC(y2, rr, S[10], 10); DPP_FMAC(y3, rr, S[11], 11);
                DPP_FMAC(y0, rr, S[12], 12); DPP_FMAC(y1, rr, S[13], 13); DPP_FMAC(y2, rr, S[14], 14); DPP_FMAC(y3, rr, S[15], 15);
            }
            const float y = xrow_sum((y0 + y1) + (y2 + y3));
            if (lane < 16) yo[SCAN_T(st) * A_W] = (bf16_t)f2bf(y);
            { const int sn = st + PD < SEQ ? st + PD : SEQ - 1; SCAN_LOAD(s, sn); }
            SCAN_OPS((s + 1) % PD);
        }
    }
#undef SCAN_T
#undef SCAN_LOAD
#undef SCAN_OPS
}
DI void phase_scan(const Ctx& C, const Args& A, int e) {
    for (int hp = C.bid; hp < NSEQ * 16; hp += C.G) {
        const int sq = hp >> 4, h = hp & 15, wv = C.wave & 3;
        if (C.wave < 4) scan_task<0>(C, A, e, sq, h, wv); else scan_task<1>(C, A, e, sq, h, wv);
    }
}

DI void phase_rwkv_post(const Ctx& C, const Args& A, int e) {
    const bf16_t* RK = (const bf16_t*)(A.ws + WS_HB); const unsigned short* AF = (const unsigned short*)(A.ws + WS_EWA) + (size_t)2 * T * A_W;
    const bf16_t* YF = (const bf16_t*)(A.ws + WS_YF); const bf16_t* YB = (const bf16_t*)(A.ws + WS_YBK); const bf16_t* GT = (const bf16_t*)(A.ws + WS_GATE);
    bf16_t* YAB = (bf16_t*)(A.ws + WS_YAB);
    const float* k_a = A.in[10] + (size_t)e * A_W; const float* r_k = A.in[11] + (size_t)e * A_W; const float* gg = A.in[12] + (size_t)e * A_W; const float* gb = A.in[13] + (size_t)e * A_W;
    for (int task = C.gw; task < T * 16; task += C.NGW) {
        const int t = task >> 4, h = task & 15, c = h * 64 + C.lane;
        const float y = bf2f(YF[(size_t)t * A_W + c]) + bf2f(YB[(size_t)t * A_W + c]);
        const float mu = wave_sum(y) * (1.f / 64.f); const float d = y - mu; const float var = wave_sum(d * d) * (1.f / 64.f);
        const float yn = d * (1.0f / sqrtf(var + A_GN_EPS)) * gg[c] + gb[c];
        const float r = bf2f(RK[(size_t)t * NB_COLS + c]), k = bf2f(RK[(size_t)t * NB_COLS + 1024 + c]), v = bf2f(RK[(size_t)t * NB_COLS + 2048 + c]);
        const float a = h2f(AF[(size_t)t * A_W + c]);
        const float kf = k * (1.0f + (a - 1.0f) * k_a[c]);
        const float bs = wave_sum(r * kf * r_k[c]);
        const float o = (yn + bs * v) * bf2f(GT[(size_t)t * A_W + c]);
        YAB[(size_t)t * D + c] = (bf16_t)f2bf(o);
    }
}

DI void phase_ffn_act(const Ctx& C, const Args& A, int l) {
    const bf16_t* H = (const bf16_t*)(A.ws + WS_HFF); bf16_t* ACT = (bf16_t*)(A.ws + WS_ACT);
    const float* cw = A.in[23] + (size_t)l * 3 * D_FF; const float* cb = A.in[24] + (size_t)l * D_FF;
    constexpr int C8 = D_FF / 8;
    for (size_t i = C.gt; i < (size_t)FG_T * C8; i += C.NGT) {
        const int t = (int)(i / C8), c = (int)(i % C8) * 8, pos = t & (SEQ - 1);
        float x0[8], x1[8], x2[8], up[8];
        const u32x4 z = (u32x4){0u, 0u, 0u, 0u};
        unpack8(pos > 0 ? *(const u32x4*)(H + (size_t)(t - 1) * FF2 + c) : z, x0);
        unpack8(*(const u32x4*)(H + (size_t)t * FF2 + c), x1);
        unpack8(pos < SEQ - 1 ? *(const u32x4*)(H + (size_t)(t + 1) * FF2 + c) : z, x2);
        unpack8(*(const u32x4*)(H + (size_t)t * FF2 + D_FF + c), up);
        float y[8];
#pragma unroll
        for (int j = 0; j < 8; ++j) { const float g = cw[c + j] * x0[j] + cw[D_FF + c + j] * x1[j] + cw[2 * D_FF + c + j] * x2[j] + cb[c + j];
            y[j] = 0.5f * g * (1.0f + erff(g * 0.70710678118654752f)) * up[j]; }
        u32x4 w; w.x = pk2(y[0], y[1]); w.y = pk2(y[2], y[3]); w.z = pk2(y[4], y[5]); w.w = pk2(y[6], y[7]);
        *(u32x4*)(ACT + (size_t)t * D_FF + c) = w;
    }
}

DI void phase_ret_scan(const Ctx& C, const Args& A) {
    const float* KVF = (const float*)(A.ws + WS_KVF); const float* KVB = (const float*)(A.ws + WS_KVB); bf16_t* BC = (bf16_t*)(A.ws + WS_BCAT);
    constexpr size_t PER = (size_t)512 * 256 / 4;
    for (size_t i = C.gt; i < (size_t)OG_SEQ * 8 * PER; i += C.NGT) {
        const int sh = (int)(i / PER), h = sh & 7; const size_t rem = i % PER; const int dv = (int)(rem >> 6), dk = (int)(rem & 63) * 4;
        const float gC = exp2f(256.0f * l2gamma(h));
        f32x4 f = (f32x4){0.f, 0.f, 0.f, 0.f};
        for (int n = 0; n < 16; ++n) { const size_t item = (size_t)sh * 16 + n;
            u32x2 w; w.x = pk2(f[0], f[1]); w.y = pk2(f[2], f[3]); *(u32x2*)(BC + (item * 512 + dv) * CATK + 256 + dk) = w;
            f = f * gC + *(const f32x4*)(KVF + (item * 512 + dv) * 256 + dk); }
        f = (f32x4){0.f, 0.f, 0.f, 0.f};
        for (int n = 15; n >= 0; --n) { const size_t item = (size_t)sh * 16 + n;
            u32x2 w; w.x = pk2(f[0], f[1]); w.y = pk2(f[2], f[3]); *(u32x2*)(BC + (item * 512 + dv) * CATK + 512 + dk) = w;
            f = f * gC + *(const f32x4*)(KVB + (item * 512 + dv) * 256 + dk); }
    }
}

DI void phase_ret_post(const Ctx& C, const Args& A, int e) {
    const float* Y = (const float*)(A.ws + WS_Y); const bf16_t* GS = (const bf16_t*)(A.ws + WS_GS); bf16_t* OB = (bf16_t*)(A.ws + WS_OB);
    const float* gg = A.in[17] + (size_t)e * C_V; const float* gb = A.in[18] + (size_t)e * C_V;
    for (int task = C.gw; task < OG_T * 8; task += C.NGW) {
        const int t = task >> 3, h = task & 7; const size_t off = (size_t)t * C_V + h * 512 + C.lane * 8;
        const f32x4 a = *(const f32x4*)(Y + off), b = *(const f32x4*)(Y + off + 4);
        const float mu = wave_sum((a[0] + a[1]) + (a[2] + a[3]) + (b[0] + b[1]) + (b[2] + b[3])) * (1.f / 512.f);
        const f32x4 da = a - mu, db = b - mu;
        const float var = wave_sum((da[0] * da[0] + da[1] * da[1]) + (da[2] * da[2] + da[3] * da[3]) + (db[0] * db[0] + db[1] * db[1]) + (db[2] * db[2] + db[3] * db[3])) * (1.f / 512.f);
        const float rs = 1.0f / sqrtf(var + LN_EPS);
        const int cc = h * 512 + C.lane * 8;
        const f32x4 g0 = *(const f32x4*)(gg + cc), g1 = *(const f32x4*)(gg + cc + 4), b0 = *(const f32x4*)(gb + cc), b1 = *(const f32x4*)(gb + cc + 4);
        float gs[8]; unpack8(*(const u32x4*)(GS + off), gs);
        const f32x4 o0 = (da * rs * g0 + b0), o1 = (db * rs * g1 + b1);
        u32x4 w; w.x = pk2(o0[0] * gs[0], o0[1] * gs[1]); w.y = pk2(o0[2] * gs[2], o0[3] * gs[3]); w.z = pk2(o1[0] * gs[4], o1[1] * gs[5]); w.w = pk2(o1[2] * gs[6], o1[3] * gs[7]);
        *(u32x4*)(OB + off) = w;
    }
}

DI bool step_ctx(Ctx& C, const Ctx& B) {
    int bid = B.bid, G = B.G, tid = B.tid;
    asm volatile("" : "+s"(bid), "+s"(G), "+v"(tid));
    C.lds = B.lds; C.tid = tid; C.lane = tid & 63; C.wave = __builtin_amdgcn_readfirstlane(tid >> 6); C.G = G; C.bid = bid;
    C.gw = bid * NWAVES + C.wave; C.NGW = G * NWAVES; C.gt = (size_t)bid * (NWAVES * 64) + tid; C.NGT = (size_t)G * NWAVES * 64;
    return true;
}
constexpr int N_STEPS = 1 + 2 * (1 + 8 + 4 * FG_N) + 2 * (1 + 7 * OG_N + 4 * FG_N);
__global__ void __launch_bounds__(NWAVES * 64, 2) mk_fwd(Args args) {
    extern __shared__ __attribute__((aligned(16))) unsigned char lds_raw[];
    Ctx C;
    C.lds = (LAS unsigned char*)lds_raw;
    C.tid = threadIdx.x; C.lane = C.tid & 63; C.wave = __builtin_amdgcn_readfirstlane(C.tid >> 6);
    C.G = gridDim.x; C.bid = blockIdx.x;
    C.gw = C.bid * NWAVES + C.wave; C.NGW = C.G * NWAVES;
    C.gt = (size_t)C.bid * (NWAVES * 64) + C.tid; C.NGT = (size_t)C.G * NWAVES * 64;
    volatile LAS unsigned* MISC = (volatile LAS unsigned*)(C.lds + MISC_OFF);
    for (int u = C.tid; u < (LDS_BYTES - LDSCTL_OFF) / 4; u += NWAVES * 64) ((LAS unsigned*)(C.lds + LDSCTL_OFF))[u] = 0u;
    __syncthreads();
    const int lo = args.lo, hi = args.hi;
    unsigned* barw = (unsigned*)(args.ws + WS_CTL) + CW_BAR;
    XcdBarrier bar; bar.bar = barw; bar.x = 0; bar.st = MISC + 8;
    if (hi - lo > 1) bar = xcd_barrier_post(barw, MISC + 8);
    LAS unsigned char* ring = C.lds;
    const Ctx Cb = C;
    int step = 0;
#define STEP_IF(kind) if (step >= lo && step < hi) for (int rep_ = 0; rep_ < 1 + (int)((PROBE_REP_MASK >> (kind)) & 1u); ++rep_) if (unsigned char* ws = opaque_ptr(args.ws)) if (step_ctx(C, Cb))
#define STEP_END do { if (step >= lo && step + 1 < hi) xcd_barrier(bar); ++step; } while (0)

    STEP_IF(0) { phase_init(C, args); } STEP_END;
    for (int l = 0; l < DEPTH; ++l) {
        const int e = l >> 1;
        STEP_IF(1) { phase_wprep(C, args, l); } STEP_END;
        if (!(l & 1)) {
            STEP_IF(2) {
                pg8::FlatOrder S; S.init(ws + WS_XB, ws + WE_IN, D, D, T, AB_IN, C.G, C.bid);
                EpiBf16Split E{(bf16_t*)(ws + WS_HA), A_COLS, (bf16_t*)(ws + WS_HB), NB_COLS, A_COLS / 256};
                pg8::gemm_phase(ring, pg8::Gemm{D, D, D}, S, E, C.tid);
            } STEP_END;
            STEP_IF(3) { phase_na(C, args, e); } STEP_END;
            STEP_IF(4) { phase_conv_a(C, args, e); } STEP_END;
            STEP_IF(5) {
                pg8::FlatOrder S; S.init(ws + WS_LIN, ws + WE_LORA, LORA_K, LORA_K, T, LORA_N, C.G, C.bid);
                EpiLora E{(unsigned short*)(ws + WS_EWA), (unsigned short*)(ws + WS_GATE), args.in[4] + (size_t)e * 2 * A_W, args.in[6] + (size_t)e * 2 * A_W};
                pg8::gemm_phase(ring, pg8::Gemm{LORA_K, LORA_K, LORA_K}, S, E, C.tid);
            } STEP_END;
            STEP_IF(6) { phase_scan(C, args, e); } STEP_END;
            STEP_IF(7) { phase_rwkv_post(C, args, e); } STEP_END;
            STEP_IF(8) {
                pg8::FlatOrder S; S.init(ws + WS_YAB, ws + WE_OUT, D, D, T, D, C.G, C.bid);
                EpiResF32 E{args.out, D, DN_ALPHA};
                pg8::gemm_phase(ring, pg8::Gemm{D, D, D}, S, E, C.tid);
            } STEP_END;
            STEP_IF(9) { phase_ln(C, args, 0, T, args.in[20] + (size_t)l * D, args.in[21] + (size_t)l * D); } STEP_END;
        } else {
            for (int g = 0; g < OG_N; ++g) {
                const size_t row0 = (size_t)g * OG_T;
                STEP_IF(10) {
                    { pg8::FlatOrder S; S.init(ws + WS_XB + row0 * D * 2, ws + WO_IN, D, D, OG_T, 8192, C.G, C.bid);
                      EpiO1a E{(bf16_t*)(ws + WS_QN), (bf16_t*)(ws + WS_KN), (bf16_t*)(ws + WS_GS), (bf16_t*)(ws + WS_ACAT), (const float*)(ws + WS_ROPE_N)};
                      pg8::gemm_phase(ring, pg8::Gemm{D, D, D}, S, E, C.tid); }
                    { pg8::FlatOrder S; S.init(ws + WO_IN + (size_t)8192 * D * 2, ws + WS_XB + row0 * D * 2, D, D, 6144, OG_T, C.G, C.bid);
                      EpiO1b E{(bf16_t*)(ws + WS_KTF), (bf16_t*)(ws + WS_KTB), (bf16_t*)(ws + WS_BCAT), (const float*)(ws + WS_ROPE_T)};
                      pg8::gemm_phase(ring, pg8::Gemm{D, D, D}, S, E, C.tid); }
                } STEP_END;
                STEP_IF(11) {
                    { RetOrder<0> S{(const char*)(ws + WS_QN), (const char*)(ws + WS_KN), C.G, C.bid}; EpiO2 E{(bf16_t*)(ws + WS_ACAT)};
                      pg8::gemm_phase(ring, pg8::Gemm{C_QK, C_QK, 256}, S, E, C.tid); }
                    { RetOrder<1> S{(const char*)(ws + WS_BCAT), (const char*)(ws + WS_KTF), C.G, C.bid}; EpiKV E{(float*)(ws + WS_KVF)};
                      pg8::gemm_phase(ring, pg8::Gemm{CATK, OG_T, 256}, S, E, C.tid); }
                    { RetOrder<1> S{(const char*)(ws + WS_BCAT), (const char*)(ws + WS_KTB), C.G, C.bid}; EpiKV E{(float*)(ws + WS_KVB)};
                      pg8::gemm_phase(ring, pg8::Gemm{CATK, OG_T, 256}, S, E, C.tid); }
                } STEP_END;
                STEP_IF(12) { phase_ret_scan(C, args); } STEP_END;
                STEP_IF(13) { RetOrder<2> S{(const char*)(ws + WS_ACAT), (const char*)(ws + WS_BCAT), C.G, C.bid}; EpiY E{(float*)(ws + WS_Y)};
                          pg8::gemm_phase(ring, pg8::Gemm{CATK, CATK, CATK}, S, E, C.tid); } STEP_END;
                STEP_IF(14) { phase_ret_post(C, args, e); } STEP_END;
                STEP_IF(15) { pg8::FlatOrder S; S.init(ws + WS_OB, ws + WO_OUT, C_V, C_V, OG_T, D, C.G, C.bid);
                          EpiResF32 E{args.out + row0 * D, D, DN_ALPHA};
                          pg8::gemm_phase(ring, pg8::Gemm{C_V, C_V, C_V}, S, E, C.tid); } STEP_END;
                STEP_IF(9) { phase_ln(C, args, (int)row0, OG_T, args.in[20] + (size_t)l * D, args.in[21] + (size_t)l * D); } STEP_END;
            }
        }
        for (int g = 0; g < FG_N; ++g) {
            const size_t row0 = (size_t)g * FG_T;
            const size_t wup = (l & 1) ? WO_UP : WE_UP, wdn = (l & 1) ? WO_DN : WE_DN;
            STEP_IF(16) { pg8::FlatOrder S; S.init(ws + WS_XB + row0 * D * 2, ws + wup, D, D, FG_T, FF2, C.G, C.bid);
                      EpiBf16Split E{(bf16_t*)(ws + WS_HFF), FF2, (bf16_t*)(ws + WS_HFF), FF2, 1 << 20};
                      pg8::gemm_phase(ring, pg8::Gemm{D, D, D}, S, E, C.tid); } STEP_END;
            STEP_IF(17) { phase_ffn_act(C, args, l); } STEP_END;
            STEP_IF(18) { pg8::FlatOrder S; S.init(ws + WS_ACT, ws + wdn, D_FF, D_FF, FG_T, D, C.G, C.bid);
                      EpiResF32 E{args.out + row0 * D, D, DN_ALPHA};
                      pg8::gemm_phase(ring, pg8::Gemm{D_FF, D_FF, D_FF}, S, E, C.tid); } STEP_END;
            STEP_IF(9) { phase_ln(C, args, (int)row0, FG_T, args.in[26] + (size_t)l * D, args.in[27] + (size_t)l * D); } STEP_END;
        }
    }
#undef STEP_IF
#undef STEP_END
}

extern "C" void kernel_launch(void* const* d_in, const int* in_sizes, int n_in, void* d_out, int out_size, void* d_ws, size_t ws_size, hipStream_t stream) {
    static int grid = 0;
    if (grid == 0) {
        if (n_in != 28 || out_size != T * D || ws_size < WS_NEED) { fprintf(stderr, "kernel_launch: unexpected shapes: n_in %d out %d ws %zu (need %zu)\n", n_in, out_size, ws_size, (size_t)WS_NEED); grid = -1; return; }
        int dev = 0, cus = 0, per_cu = 0;
        if (hipGetDevice(&dev) != hipSuccess || hipDeviceGetAttribute(&cus, hipDeviceAttributeMultiprocessorCount, dev) != hipSuccess) { grid = -1; return; }
        if (hipFuncSetAttribute((const void*)mk_fwd, hipFuncAttributeMaxDynamicSharedMemorySize, LDS_BYTES) != hipSuccess) { fprintf(stderr, "kernel_launch: hipFuncSetAttribute failed\n"); grid = -1; return; }
        if (hipOccupancyMaxActiveBlocksPerMultiprocessor(&per_cu, (const void*)mk_fwd, NWAVES * 64, LDS_BYTES) != hipSuccess || per_cu < 1) fprintf(stderr, "kernel_launch: occupancy query says %d\n", per_cu);
        (void)hipGetLastError();
        grid = cus;
    }
    if (grid < 0) return;
    (void)in_sizes;
    hipMemsetAsync((char*)d_ws + WS_CTL, 0, CTL_ZERO_BYTES, stream);
    Args a{};
    for (int i = 0; i < 28; ++i) a.in[i] = (const float*)d_in[i];
    a.out = (float*)d_out; a.ws = (unsigned char*)d_ws;
#if MK_MULTI_LAUNCH
    for (int s = 0; s < N_STEPS; ++s) { a.lo = s; a.hi = s + 1; hipLaunchKernelGGL(mk_fwd, dim3(grid), dim3(NWAVES * 64), LDS_BYTES, stream, a); }
#else
    a.lo = 0; a.hi = N_STEPS;
    hipLaunchKernelGGL(mk_fwd, dim3(grid), dim3(NWAVES * 64), LDS_BYTES, stream, a);
#endif
}
```

```cpp
#include <hip/hip_runtime.h>
#include <cstdio>
#include <cstdint>

#ifndef PROBE_REP_MASK
#define PROBE_REP_MASK 0u
#endif
#ifndef MK_MULTI_LAUNCH
#define MK_MULTI_LAUNCH 0
#endif

#define GAS __attribute__((address_space(1)))
#define LAS __attribute__((address_space(3)))
typedef unsigned short bf16_t;
typedef short bf16x8 __attribute__((ext_vector_type(8)));
typedef float f32x4 __attribute__((ext_vector_type(4)));
typedef float f32x2 __attribute__((ext_vector_type(2)));
typedef unsigned u32x4 __attribute__((ext_vector_type(4)));
typedef unsigned u32x2 __attribute__((ext_vector_type(2)));
typedef GAS unsigned gu32;
#define RLX_AGENT __ATOMIC_RELAXED, __HIP_MEMORY_SCOPE_AGENT
#define DI __device__ __forceinline__

constexpr int D = 2048, SEQ = 4096, NSEQ = 12, T = NSEQ * SEQ;
constexpr int A_W = 1024, A_COLS = 3328, AB_IN = 6400, B_W = 1024, NB_COLS = 3072;
constexpr int C_QK = 2048, C_V = 4096, C_IN = 12288;
constexpr int D_FF = 5504, FF2 = 11008;
constexpr int DEPTH = 4;
constexpr float DN_ALPHA = 1.6817928305074290f;
constexpr float LN_EPS = 1e-5f, A_GN_EPS = 64e-5f;
constexpr int GRID_W = 64;
constexpr int LORA_K = 256, LORA_N = 5120;
constexpr int OG_SEQ = 2, OG_T = OG_SEQ * SEQ, OG_N = NSEQ / OG_SEQ, RC = 256, RNC = SEQ / RC, OG_ITEMS = OG_SEQ * 8 * RNC;
constexpr int CATK = 768;

constexpr size_t MiB = 1u << 20;
constexpr size_t WS_CTL = 0, CTL_ZERO_BYTES = 1 * MiB;
constexpr size_t WS_ROPE_N = 1 * MiB;
constexpr size_t WS_ROPE_T = 5 * MiB;
constexpr size_t WS_W = 9 * MiB;
constexpr size_t WE_IN = WS_W, WE_OUT = WE_IN + (size_t)AB_IN * D * 2, WE_UP = WE_OUT + (size_t)D * D * 2, WE_DN = WE_UP + (size_t)FF2 * D * 2, WE_LORA = WE_DN + (size_t)D * D_FF * 2, WE_END = WE_LORA + (size_t)LORA_N * LORA_K * 2;
constexpr int CIN_ROWS = 14336;
constexpr size_t WO_IN = WS_W, WO_OUT = WO_IN + (size_t)CIN_ROWS * D * 2, WO_UP = WO_OUT + (size_t)D * C_V * 2, WO_DN = WO_UP + (size_t)FF2 * D * 2, WO_END = WO_DN + (size_t)D * D_FF * 2;
constexpr size_t WS_XB = 146 * MiB;
constexpr size_t WS_POOL = 338 * MiB;
static_assert(WE_END <= WS_XB && WO_END <= WS_XB, "weights region");
constexpr size_t WS_YAB = WS_XB;
constexpr size_t WS_HA = WS_POOL;
constexpr size_t WS_HB = WS_HA + (size_t)T * A_COLS * 2;
constexpr size_t WS_EWA = WS_HB + (size_t)T * NB_COLS * 2;
constexpr size_t WS_EWA_END = WS_EWA + (size_t)4 * T * A_W * 2;
constexpr size_t WS_LIN = WS_EWA_END;
constexpr size_t WS_GATE = WS_HA;
constexpr size_t WS_YF = WS_HA + (size_t)T * A_W * 2;
constexpr size_t WS_YBK = WS_YF + (size_t)T * A_W * 2;
constexpr size_t WS_KKN = WS_LIN + (size_t)T * LORA_K * 2;
constexpr size_t WS_EVEN_END = WS_KKN + (size_t)T * 16 * 4;
constexpr int FF_NT = D_FF / 128;
constexpr size_t WS_ACT = WS_POOL;
constexpr size_t WS_EDGE = WS_ACT + (size_t)T * D_FF * 2;
constexpr size_t WS_FFN_END = WS_EDGE + (size_t)(T / 256) * FF_NT * 6 * 128 * 4;
constexpr size_t WS_QN = WS_POOL;
constexpr size_t WS_KN = WS_QN + (size_t)OG_T * C_QK * 2;
constexpr size_t WS_GS = WS_KN + (size_t)OG_T * C_QK * 2;
constexpr size_t WS_ACAT = WS_GS + (size_t)OG_T * C_V * 2;
constexpr size_t WS_BCAT = WS_ACAT + (size_t)OG_ITEMS * 256 * CATK * 2;
constexpr size_t WS_KTF = WS_BCAT + (size_t)OG_ITEMS * 512 * CATK * 2;
constexpr size_t WS_KTB = WS_KTF + (size_t)C_QK * OG_T * 2;
constexpr size_t WS_KVF = WS_KTB + (size_t)C_QK * OG_T * 2;
constexpr size_t WS_KVB = WS_KVF + (size_t)OG_ITEMS * 512 * 256 * 4;
constexpr size_t WS_Y = WS_KVB + (size_t)OG_ITEMS * 512 * 256 * 4;
constexpr size_t WS_OB = WS_Y + (size_t)OG_T * C_V * 4;
constexpr size_t WS_ODD_END = WS_OB + (size_t)OG_T * C_V * 2;
constexpr size_t WS_NEED = 1376 * MiB;
static_assert(WS_EVEN_END <= WS_NEED && WS_FFN_END <= WS_NEED && WS_ODD_END <= WS_NEED, "d_ws map");
constexpr int CW_TMO = 0, CW_BAR = 4096;

constexpr int RING_BYTES = 131072;
constexpr int LDSCTL_OFF = RING_BYTES, MISC_OFF = LDSCTL_OFF + 320, EB_OFF = LDSCTL_OFF + 512;
constexpr int LDS_BYTES = 147456;
constexpr int NWAVES = 8;

DI unsigned f2bf(float f) { unsigned u = __builtin_bit_cast(unsigned, f); return (u + 0x7fffu + ((u >> 16) & 1u)) >> 16; }
DI unsigned pk2(float lo, float hi) { return f2bf(lo) | (f2bf(hi) << 16); }
DI float bf2f(unsigned short b) { return __builtin_bit_cast(float, ((unsigned)b) << 16); }
DI float bflo(unsigned w) { return __builtin_bit_cast(float, w << 16); }
DI float bfhi(unsigned w) { return __builtin_bit_cast(float, w & 0xffff0000u); }
DI unsigned cvt_pk_bf16(float lo, float hi) { unsigned r; asm volatile("v_cvt_pk_bf16_f32 %0, %1, %2" : "=v"(r) : "v"(lo), "v"(hi)); return r; }
DI unsigned pk2h(float lo, float hi) { typedef _Float16 h2 __attribute__((ext_vector_type(2))); h2 v; v.x = (_Float16)lo; v.y = (_Float16)hi; return __builtin_bit_cast(unsigned, v); }
DI float h2f(unsigned short h) { return (float)__builtin_bit_cast(_Float16, h); }
DI float wave_sum(float v) {
#pragma unroll
    for (int o = 1; o < 64; o <<= 1) v += __shfl_xor(v, o);
    return v;
}
template <class P> DI P* opaque_ptr(P* p) { asm volatile("" : "+s"(p)); return p; }
DI float sigmoidf_(float x) { return 1.0f / (1.0f + __expf(-x)); }

namespace pg8 {
constexpr int BM = 256, BK = 64, HALF = 128, HTB = HALF * BK * 2, STAGE_BYTES = 8 * HTB, NXCD = 8, WGM = 8;
DI int lds_byte(int r, int c) { const int st = (r >> 4) * 2 + (c >> 5), rr = r & 15, cc = c & 31, ob = rr * 64 + cc * 2; return st * 1024 + (ob ^ (((ob >> 9) & 1) << 5)); }
DI void stage_rc(int b, int& R, int& C) { const int st = b / 1024, sb = b % 1024, swz = sb ^ (((sb >> 9) & 1) << 5); R = (st >> 1) * 16 + swz / 64; C = (st & 1) * 32 + (swz % 64) / 2; }
DI int perm32(int rho) { const int n = rho >> 4, i = rho & 15; return 8 * (i >> 2) + 4 * n + (i & 3); }

struct Unit { int pm, pn, item; const char* a; const char* b; };
struct Gemm { int lda, ldb, K; };

struct FlatOrder {
    const char* A; const char* Bt; int lda, ldb; int nM, nN, nwg, G, c;
    DI void init(const void* A_, const void* Bt_, int lda_, int ldb_, int M, int N, int G_, int c_) { A = (const char*)A_; Bt = (const char*)Bt_; lda = lda_; ldb = ldb_; nM = M / BM; nN = N / BM; nwg = nM * nN; G = G_; c = c_; }
    DI bool next(int i, Unit& u) const {
        const long L = (long)i * G + c; if (L >= nwg) return false;
        int wgid = (int)L; { const int q = nwg / NXCD, r = nwg % NXCD, xcd = wgid % NXCD, off = wgid / NXCD; wgid = (xcd < r ? xcd * (q + 1) : r * (q + 1) + (xcd - r) * q) + off; }
        const int nig = WGM * nN, gid = wgid / nig, fm = gid * WGM, gsz = (nM - fm) < WGM ? (nM - fm) : WGM;
        u.pm = fm + ((wgid % nig) % gsz); u.pn = (wgid % nig) / gsz; u.item = 0;
        u.a = A + (size_t)u.pm * BM * lda * 2; u.b = Bt + (size_t)u.pn * BM * ldb * 2; return true;
    }
};

#define PG8_WAIT_V(n) asm volatile("s_waitcnt vmcnt(" #n ")" ::: "memory")
#define PG8_WAIT_L(n) asm volatile("s_waitcnt lgkmcnt(" #n ")" ::: "memory")
#define PG8_BAR __builtin_amdgcn_s_barrier()
#define PG8_SCHED __builtin_amdgcn_sched_barrier(0)

template <class Epi, class Sched>
DI void gemm_phase(LAS unsigned char* lds, const Gemm g, const Sched& S, const Epi& E, const int tid) {
    const int wid = __builtin_amdgcn_readfirstlane(tid >> 6), lane = tid & 63, wr = wid >> 2, wc = wid & 3, fr = lane & 15, fq = lane >> 4;
    int K = g.K; asm volatile("" : "+s"(K));
    const int nt = K / BK;
    unsigned voffA[2], voffB[2];
#pragma unroll
    for (int i = 0; i < 2; ++i) { int R, C; stage_rc(tid * 16 + i * 8192, R, C); const int Rb = Epi::PERM ? ((R & ~31) + perm32(R & 31)) : R;
        voffA[i] = (unsigned)(R * g.lda + C) * 2u; voffB[i] = (unsigned)(Rb * g.ldb + C) * 2u; }
    const size_t kstep = (size_t)(BK * 2);
    const size_t hstepA = (size_t)HALF * g.lda * 2, hstepB = (size_t)HALF * g.ldb * 2;
    const unsigned ldsw = (unsigned)wid * 1024u;
    const int aoff = lds_byte(wr * 64 + fr, fq * 8), boff = lds_byte(wc * 32 + fr, fq * 8);
#define PG8_SA(b, h) (((b) * 2 + (h)) * HTB)
#define PG8_SB(b, h) ((4 + (b) * 2 + (h)) * HTB)
#define PG8_STAGE(bufoff, gbase, voff) do { _Pragma("unroll") for (int _i = 0; _i < 2; ++_i) \
        __builtin_amdgcn_global_load_lds((const unsigned*)((const char*)(gbase) + (voff)[_i]), (LAS unsigned*)(lds + (bufoff) + ldsw + _i * 8192), 16, 0, 0); } while (0)
#define PG8_LDA(dst, b, h) do { _Pragma("unroll") for (int m = 0; m < 4; ++m) _Pragma("unroll") for (int k = 0; k < 2; ++k) dst[m][k] = *(const LAS bf16x8*)(lds + PG8_SA(b, h) + aoff + m * 2048 + k * 1024); } while (0)
#define PG8_LDB(dst, b, h) do { _Pragma("unroll") for (int n = 0; n < 2; ++n) _Pragma("unroll") for (int k = 0; k < 2; ++k) dst[n][k] = *(const LAS bf16x8*)(lds + PG8_SB(b, h) + boff + n * 2048 + k * 1024); } while (0)
#define PG8_MMA(ai, bj, At, Bt) do { __builtin_amdgcn_s_setprio(1); _Pragma("unroll") for (int m = 0; m < 4; ++m) _Pragma("unroll") for (int n = 0; n < 2; ++n) _Pragma("unroll") for (int k = 0; k < 2; ++k) \
        acc[ai][bj][m][n] = __builtin_amdgcn_mfma_f32_16x16x32_bf16(Bt[n][k], At[m][k], acc[ai][bj][m][n], 0, 0, 0); __builtin_amdgcn_s_setprio(0); } while (0)
    Unit cur, nxt; int ui = 0;
    if (!S.next(0, cur)) return;
    f32x4 acc[2][2][4][2];
#pragma unroll
    for (int a = 0; a < 2; ++a)
#pragma unroll
        for (int b = 0; b < 2; ++b)
#pragma unroll
            for (int m = 0; m < 4; ++m)
#pragma unroll
                for (int n = 0; n < 2; ++n) acc[a][b][m][n] = (f32x4){0.f, 0.f, 0.f, 0.f};
    bf16x8 At[4][2], B0[2][2], B1[2][2];
    const char* cA = cur.a; const char* cB = cur.b;
    PG8_STAGE(PG8_SB(0, 0), cB, voffB); PG8_STAGE(PG8_SB(0, 1), cB + hstepB, voffB); PG8_STAGE(PG8_SA(0, 0), cA, voffA); PG8_STAGE(PG8_SA(0, 1), cA + hstepA, voffA);
    if (wr == 1) PG8_BAR;
    PG8_WAIT_V(2); PG8_BAR;
    PG8_STAGE(PG8_SB(1, 0), cB + kstep, voffB); PG8_STAGE(PG8_SA(1, 0), cA + kstep, voffA); PG8_STAGE(PG8_SB(1, 1), cB + hstepB + kstep, voffB);
    PG8_WAIT_V(6); PG8_BAR;
    for (;;) {
        const bool has_next = S.next(ui + 1, nxt);
        const char* nA = has_next ? nxt.a : cA; const char* nB = has_next ? nxt.b : cB;
        for (int t = 0; t < nt; t += 2) {
            const bool last = (t == nt - 2);
            const char* a1 = cA + (size_t)(t + 1) * kstep;
            const char* a2 = last ? nA : cA + (size_t)(t + 2) * kstep; const char* b2 = last ? nB : cB + (size_t)(t + 2) * kstep;
            const char* a3 = a2 + kstep; const char* b3 = b2 + kstep;
            PG8_LDB(B0, 0, 0); PG8_LDB(B1, 0, 1); PG8_SCHED; PG8_LDA(At, 0, 0); PG8_STAGE(PG8_SA(1, 1), a1 + hstepA, voffA);
            PG8_WAIT_V(8); PG8_WAIT_L(0); PG8_BAR; PG8_MMA(0, 0, At, B0); PG8_MMA(0, 1, At, B1); PG8_BAR; PG8_SCHED;
            PG8_LDA(At, 0, 1); PG8_STAGE(PG8_SB(0, 0), b2, voffB); PG8_STAGE(PG8_SB(0, 1), b2 + hstepB, voffB); PG8_STAGE(PG8_SA(0, 0), a2, voffA);
            PG8_WAIT_V(8); PG8_WAIT_L(0); PG8_BAR; PG8_MMA(1, 0, At, B0); PG8_MMA(1, 1, At, B1); PG8_BAR; PG8_SCHED;
            PG8_LDB(B0, 1, 0); PG8_LDB(B1, 1, 1); PG8_SCHED; PG8_LDA(At, 1, 0); PG8_STAGE(PG8_SA(0, 1), a2 + hstepA, voffA);
            PG8_WAIT_V(8); PG8_WAIT_L(0); PG8_BAR; PG8_MMA(0, 0, At, B0); PG8_MMA(0, 1, At, B1); PG8_BAR; PG8_SCHED;
            PG8_LDA(At, 1, 1); PG8_STAGE(PG8_SB(1, 0), b3, voffB); PG8_STAGE(PG8_SB(1, 1), b3 + hstepB, voffB); PG8_STAGE(PG8_SA(1, 0), a3, voffA);
            PG8_WAIT_V(8); PG8_WAIT_L(0); PG8_BAR; PG8_MMA(1, 0, At, B0); PG8_MMA(1, 1, At, B1); PG8_BAR; PG8_SCHED;
        }
        if (wr == 0) PG8_BAR;
        { int fr_ = fr, fq_ = fq; asm volatile("" : "+v"(fr_), "+v"(fq_));
          E(acc, cur, wr, wc, fr_, fq_); }
        if (!has_next) break;
#pragma unroll
        for (int a = 0; a < 2; ++a)
#pragma unroll
            for (int b = 0; b < 2; ++b)
#pragma unroll
                for (int m = 0; m < 4; ++m)
#pragma unroll
                    for (int n = 0; n < 2; ++n) acc[a][b][m][n] = (f32x4){0.f, 0.f, 0.f, 0.f};
        cur = nxt; cA = nA; cB = nB; ++ui;
        if (wr == 1) PG8_BAR;
    }
    PG8_WAIT_V(0);
    PG8_BAR;
#undef PG8_SA
#undef PG8_SB
#undef PG8_STAGE
#undef PG8_LDA
#undef PG8_LDB
#undef PG8_MMA
}
}

typedef const f32x4 (&AccRef)[2][2][4][2];
DI u32x4 pack8(f32x4 v0, f32x4 v1) { u32x4 w; w.x = cvt_pk_bf16(v0[0], v0[1]); w.y = cvt_pk_bf16(v0[2], v0[3]); w.z = cvt_pk_bf16(v1[0], v1[1]); w.w = cvt_pk_bf16(v1[2], v1[3]); return w; }
DI u32x4 pack8h(f32x4 v0, f32x4 v1) { u32x4 w; w.x = pk2h(v0[0], v0[1]); w.y = pk2h(v0[2], v0[3]); w.z = pk2h(v1[0], v1[1]); w.w = pk2h(v1[2], v1[3]); return w; }

struct EpiBf16Split {
    static constexpr bool PERM = true;
    bf16_t* O0; int ld0; bf16_t* O1; int ld1; int split;
    DI void operator()(AccRef acc, const pg8::Unit& u, int wr, int wc, int fr, int fq) const {
        const int row0 = u.pm * 256 + wr * 64 + fr;
        bf16_t* base; int ld, colt;
        if (u.pn < split) { base = O0; ld = ld0; colt = u.pn * 256; } else { base = O1; ld = ld1; colt = (u.pn - split) * 256; }
        const int col0 = colt + wc * 32 + 8 * fq;
#pragma unroll
        for (int ai = 0; ai < 2; ++ai)
#pragma unroll
            for (int m = 0; m < 4; ++m) { bf16_t* rowp = base + (size_t)(row0 + ai * 128 + m * 16) * ld + col0;
#pragma unroll
                for (int bj = 0; bj < 2; ++bj) *(u32x4*)(rowp + bj * 128) = pack8(acc[ai][bj][m][0], acc[ai][bj][m][1]); }
    }
};

struct EpiResF32 {
    static constexpr bool PERM = false;
    float* out; int ldc; float alpha;
    DI void operator()(AccRef acc, const pg8::Unit& u, int wr, int wc, int fr, int fq) const {
        const int row0 = u.pm * 256 + wr * 64 + fr, col0 = u.pn * 256 + wc * 32 + 4 * fq;
#pragma unroll
        for (int ai = 0; ai < 2; ++ai)
#pragma unroll
            for (int m = 0; m < 4; ++m) { float* rowp = out + (size_t)(row0 + ai * 128 + m * 16) * ldc + col0;
#pragma unroll
                for (int bj = 0; bj < 2; ++bj)
#pragma unroll
                    for (int n = 0; n < 2; ++n) { f32x4* p = (f32x4*)(rowp + bj * 128 + n * 16); const f32x4 x = *p; *p = x * alpha + acc[ai][bj][m][n]; }
                asm volatile("" ::: "memory"); }
    }
};

struct EpiLora {
    static constexpr bool PERM = true;
    unsigned short* ewa; unsigned short* gate; const float* w0; const float* a0;
    DI void operator()(AccRef acc, const pg8::Unit& u, int wr, int wc, int fr, int fq) const {
        const int type = u.pn >> 2, cbase = (u.pn & 3) * 256 + wc * 32 + 8 * fq;
        const int row0 = u.pm * 256 + wr * 64 + fr;
        unsigned short* base = (type < 4) ? ewa + (size_t)type * T * A_W : gate;
        const float* bias = (type < 2) ? w0 + type * A_W : a0 + ((type - 2) & 1) * A_W;
#pragma unroll
        for (int bj = 0; bj < 2; ++bj) {
            const int cc = cbase + bj * 128;
            f32x4 b0 = (f32x4){0.f, 0.f, 0.f, 0.f}, b1 = b0;
            if (type < 4) { b0 = *(const f32x4*)(bias + cc); b1 = *(const f32x4*)(bias + cc + 4); }
#pragma unroll
            for (int ai = 0; ai < 2; ++ai)
#pragma unroll
                for (int m = 0; m < 4; ++m) {
                    f32x4 v0 = acc[ai][bj][m][0] + b0, v1 = acc[ai][bj][m][1] + b1;
                    u32x4 w;
                    if (type < 2) {
#pragma unroll
                        for (int e = 0; e < 4; ++e) { { const float z = -v0[e]; const float sp = fmaxf(z, 0.f) + __logf(1.0f + __expf(-fabsf(z))); v0[e] = __expf(-sp - 0.5f); }
                                                       { const float z = -v1[e]; const float sp = fmaxf(z, 0.f) + __logf(1.0f + __expf(-fabsf(z))); v1[e] = __expf(-sp - 0.5f); } }
                        w = pack8h(v0, v1);
                    } else if (type < 4) {
#pragma unroll
                        for (int e = 0; e < 4; ++e) { v0[e] = sigmoidf_(v0[e]); v1[e] = sigmoidf_(v1[e]); }
                        w = pack8h(v0, v1);
                    } else w = pack8(v0, v1);
                    *(u32x4*)(base + (size_t)(row0 + ai * 128 + m * 16) * A_W + cc) = w;
                    __builtin_amdgcn_sched_barrier(0);
                }
        }
    }
};

DI float l2gamma(int h) { return log1pf(-exp2f((float)(-5 - h))) * 1.4426950408889634f; }

struct EpiO1a {
    static constexpr bool PERM = true;
    bf16_t* QN; bf16_t* KN; bf16_t* GS; bf16_t* ACAT; const float* ropeN;
    DI void operator()(AccRef acc, const pg8::Unit& u, int wr, int wc, int fr, int fq) const {
        const int rbase = u.pm * 256 + wr * 64 + fr;
        if (u.pn >= 16) {
            const int col0 = (u.pn - 16) * 256 + wc * 32 + 8 * fq;
#pragma unroll
            for (int ai = 0; ai < 2; ++ai)
#pragma unroll
                for (int m = 0; m < 4; ++m) { bf16_t* rowp = GS + (size_t)(rbase + ai * 128 + m * 16) * C_V + col0;
#pragma unroll
                    for (int bj = 0; bj < 2; ++bj) { f32x4 v0 = acc[ai][bj][m][0], v1 = acc[ai][bj][m][1];
#pragma unroll
                        for (int e = 0; e < 4; ++e) { v0[e] = v0[e] * sigmoidf_(v0[e]); v1[e] = v1[e] * sigmoidf_(v1[e]); }
                        *(u32x4*)(rowp + bj * 128) = pack8(v0, v1); } }
            return;
        }
        const bool isq = u.pn < 8; const int h = u.pn & 7;
        const int i0 = wc * 32 + 8 * fq;
        const float l2g = l2gamma(h);
        const int seq_l = u.pm >> 4, nch = u.pm & 15; const size_t item = (size_t)((seq_l * 8 + h) * 16 + nch);
        bf16_t* nat = (isq ? QN : KN);
        const float ksc = isq ? 1.0f : 0.0625f;
#pragma unroll
        for (int ai = 0; ai < 2; ++ai)
#pragma unroll
            for (int m = 0; m < 4; ++m) {
                const int r = rbase + ai * 128 + m * 16, pos = r & (SEQ - 1), p = r & 255;
                const float* cp = ropeN + (size_t)pos * 128 + i0; const float* sp = cp + (size_t)SEQ * 128;
                const f32x4 c0 = *(const f32x4*)cp, c1 = *(const f32x4*)(cp + 4), s0 = *(const f32x4*)sp, s1 = *(const f32x4*)(sp + 4);
                const f32x4 x10 = acc[ai][0][m][0], x11 = acc[ai][0][m][1], x20 = acc[ai][1][m][0], x21 = acc[ai][1][m][1];
                const f32x4 o10 = (x10 * c0 - x20 * s0) * ksc, o11 = (x11 * c1 - x21 * s1) * ksc, o20 = (x10 * s0 + x20 * c0) * ksc, o21 = (x11 * s1 + x21 * c1) * ksc;
                bf16_t* rowp = nat + (size_t)r * C_QK + h * 256 + i0;
                *(u32x4*)(rowp) = pack8(o10, o11); *(u32x4*)(rowp + 128) = pack8(o20, o21);
                if (isq) {
                    const float gf = exp2f((float)(p + 1) * l2g), gb = exp2f((float)(256 - p) * l2g);
                    bf16_t* ap = ACAT + (item * 256 + p) * CATK + i0;
                    *(u32x4*)(ap + 256) = pack8(o10 * gf, o11 * gf); *(u32x4*)(ap + 256 + 128) = pack8(o20 * gf, o21 * gf);
                    *(u32x4*)(ap + 512) = pack8(o10 * gb, o11 * gb); *(u32x4*)(ap + 512 + 128) = pack8(o20 * gb, o21 * gb);
                }
            }
    }
};

struct EpiO1b {
    static constexpr bool PERM = true;
    bf16_t* KTF; bf16_t* KTB; bf16_t* BCAT; const float* ropeT;
    DI void operator()(AccRef acc, const pg8::Unit& u, int wr, int wc, int fr, int fq) const {
        const int tc0 = u.pn * 256 + wc * 32 + 8 * fq;
        if (u.pm >= 8) {
            const int vt = u.pm - 8, h = vt >> 1, dvb = (vt & 1) * 256 + wr * 64 + fr;
            const int seq_l = u.pn >> 4, nch = u.pn & 15; const size_t item = (size_t)((seq_l * 8 + h) * 16 + nch);
            const int p0 = wc * 32 + 8 * fq;
#pragma unroll
            for (int ai = 0; ai < 2; ++ai)
#pragma unroll
                for (int m = 0; m < 4; ++m) { bf16_t* rowp = BCAT + (item * 512 + dvb + ai * 128 + m * 16) * CATK + p0;
#pragma unroll
                    for (int bj = 0; bj < 2; ++bj) *(u32x4*)(rowp + bj * 128) = pack8(acc[ai][bj][m][0], acc[ai][bj][m][1]); }
            return;
        }
        const int h = u.pm; const float l2g = l2gamma(h);
#pragma unroll
        for (int bj = 0; bj < 2; ++bj) {
            const int tc = tc0 + bj * 128, pos = tc & (SEQ - 1), p = tc & 255;
            f32x4 gf0, gf1, gb0, gb1;
#pragma unroll
            for (int e = 0; e < 4; ++e) { gf0[e] = exp2f((float)(255 - (p + e)) * l2g) * 0.0625f; gf1[e] = exp2f((float)(255 - (p + 4 + e)) * l2g) * 0.0625f;
                                           gb0[e] = exp2f((float)(p + e) * l2g) * 0.0625f; gb1[e] = exp2f((float)(p + 4 + e) * l2g) * 0.0625f; }
#pragma unroll
            for (int m = 0; m < 4; ++m) {
                const int i = wr * 64 + m * 16 + fr;
                const float* cp = ropeT + (size_t)i * SEQ + pos; const float* sp = cp + (size_t)128 * SEQ;
                const f32x4 c0 = *(const f32x4*)cp, c1 = *(const f32x4*)(cp + 4), s0 = *(const f32x4*)sp, s1 = *(const f32x4*)(sp + 4);
                const f32x4 x10 = acc[0][bj][m][0], x11 = acc[0][bj][m][1], x20 = acc[1][bj][m][0], x21 = acc[1][bj][m][1];
                const f32x4 o10 = x10 * c0 - x20 * s0, o11 = x11 * c1 - x21 * s1, o20 = x10 * s0 + x20 * c0, o21 = x11 * s1 + x21 * c1;
                const size_t r1 = (size_t)(h * 256 + i) * OG_T + tc, r2 = r1 + (size_t)128 * OG_T;
                *(u32x4*)(KTF + r1) = pack8(o10 * gf0, o11 * gf1); *(u32x4*)(KTF + r2) = pack8(o20 * gf0, o21 * gf1);
                *(u32x4*)(KTB + r1) = pack8(o10 * gb0, o11 * gb1); *(u32x4*)(KTB + r2) = pack8(o20 * gb0, o21 * gb1);
            }
        }
    }
};

struct EpiO2 {
    static constexpr bool PERM = true;
    bf16_t* ACAT;
    DI void operator()(AccRef acc, const pg8::Unit& u, int wr, int wc, int fr, int fq) const {
        const int h = (u.item >> 4) & 7; const float l2g = l2gamma(h);
        const int s0 = wc * 32 + 8 * fq;
#pragma unroll
        for (int ai = 0; ai < 2; ++ai)
#pragma unroll
            for (int m = 0; m < 4; ++m) { const int t = ai * 128 + wr * 64 + m * 16 + fr; bf16_t* rowp = ACAT + ((size_t)u.item * 256 + t) * CATK + s0;
#pragma unroll
                for (int bj = 0; bj < 2; ++bj) { f32x4 v0 = acc[ai][bj][m][0], v1 = acc[ai][bj][m][1];
#pragma unroll
                    for (int e = 0; e < 4; ++e) { const int sa = s0 + bj * 128 + e; const int d0 = t - sa, d1 = t - sa - 4;
                        v0[e] *= exp2f((float)(d0 < 0 ? -d0 : d0) * l2g); v1[e] *= exp2f((float)(d1 < 0 ? -d1 : d1) * l2g); }
                    *(u32x4*)(rowp + bj * 128) = pack8(v0, v1); }
                __builtin_amdgcn_sched_barrier(0); }
    }
};

struct EpiKV {
    static constexpr bool PERM = false;
    float* KV;
    DI void operator()(AccRef acc, const pg8::Unit& u, int wr, int wc, int fr, int fq) const {
        float* base = KV + (size_t)u.item * 512 * 256 + (size_t)(u.pm * 256 + wr * 64 + fr) * 256 + wc * 32 + 4 * fq;
#pragma unroll
        for (int ai = 0; ai < 2; ++ai)
#pragma unroll
            for (int m = 0; m < 4; ++m)
#pragma unroll
                for (int bj = 0; bj < 2; ++bj)
#pragma unroll
                    for (int n = 0; n < 2; ++n) *(f32x4*)(base + (size_t)(ai * 128 + m * 16) * 256 + bj * 128 + n * 16) = acc[ai][bj][m][n];
    }
};

struct EpiY {
    static constexpr bool PERM = false;
    float* Y;
    DI void operator()(AccRef acc, const pg8::Unit& u, int wr, int wc, int fr, int fq) const {
        const int nch = u.item & 15, h = (u.item >> 4) & 7, seq_l = u.item >> 7;
        float* base = Y + (size_t)(seq_l * SEQ + nch * 256 + wr * 64 + fr) * C_V + h * 512 + u.pn * 256 + wc * 32 + 4 * fq;
#pragma unroll
        for (int ai = 0; ai < 2; ++ai)
#pragma unroll
            for (int m = 0; m < 4; ++m)
#pragma unroll
                for (int bj = 0; bj < 2; ++bj)
#pragma unroll
                    for (int n = 0; n < 2; ++n) *(f32x4*)(base + (size_t)(ai * 128 + m * 16) * C_V + bj * 128 + n * 16) = acc[ai][bj][m][n];
    }
};

template <int MODE> struct RetOrder {
    const char* P0; const char* P1; int G, c;
    DI bool next(int i, pg8::Unit& u) const {
        constexpr int UPI = (MODE == 0) ? 1 : 2;
        const int L = i * G + c; if (L >= OG_ITEMS * UPI) return false;
        const int item = L / UPI, sub = L % UPI; u.item = item;
        const int nch = item & 15, h = (item >> 4) & 7, seq_l = item >> 7; const size_t tok0 = (size_t)seq_l * SEQ + nch * 256;
        if (MODE == 0) { u.pm = 0; u.pn = 0; u.a = P0 + (tok0 * C_QK + h * 256) * 2; u.b = P1 + (tok0 * C_QK + h * 256) * 2; }
        else if (MODE == 1) { u.pm = sub; u.pn = 0; u.a = P0 + ((size_t)item * 512 + sub * 256) * CATK * 2; u.b = P1 + ((size_t)(h * 256) * OG_T + tok0) * 2; }
        else { u.pm = 0; u.pn = sub; u.a = P0 + (size_t)item * 256 * CATK * 2; u.b = P1 + ((size_t)item * 512 + sub * 256) * CATK * 2; }
        return true;
    }
};

#define XB_TMO      128
#define XB_XCNT(j)  (256  + 64 * (j))
#define XB_XSUB(j)  (1280 + 64 * (j))
#define XB_XGEN(j)  (2304 + 64 * (j))
#define XB_TOP      3328
#define XB_TOPGEN   3392
#define XCD_BAR_WORDS 3456
#define XB_SPIN_CAP (1u << 22)
DI unsigned xb_ld(unsigned* p)              { return __hip_atomic_load(p, __ATOMIC_RELAXED, __HIP_MEMORY_SCOPE_AGENT); }
DI unsigned xb_add(unsigned* p, unsigned v) { return __hip_atomic_fetch_add(p, v, __ATOMIC_RELAXED, __HIP_MEMORY_SCOPE_AGENT); }
DI unsigned xb_xcc_id() { return (unsigned)__builtin_amdgcn_s_getreg((3 << 11) | 20) & 0xFu; }
#define XB_SPIN(cond, bar) do { unsigned _sp = 0; while (cond) { __builtin_amdgcn_s_sleep(1); \
    if ((++_sp & 255u) == 0u) { if (xb_ld(&(bar)[XB_TMO])) break; if (_sp > XB_SPIN_CAP) { atomicAdd(&(bar)[XB_TMO], 1u); break; } } } } while (0)
struct XcdBarrier { unsigned* bar; unsigned x; volatile LAS unsigned* st; };
DI XcdBarrier xcd_barrier_post(unsigned* bar, volatile LAS unsigned* st) {
    XcdBarrier b; b.bar = bar; b.x = xb_xcc_id(); b.st = st;
    if (threadIdx.x == 0) (void)xb_add(&bar[XB_XCNT(b.x)], 1u);
    return b;
}
DI void xcd_barrier_complete(unsigned* bar, unsigned x, unsigned& nloc, unsigned& nx) {
    const unsigned G = gridDim.x * gridDim.y * gridDim.z;
    unsigned sum, cnt, mine, sp = 0u;
    for (;;) {
        sum = 0u; cnt = 0u; mine = 0u;
#pragma unroll
        for (unsigned j = 0; j < 16; ++j) { const unsigned c = xb_ld(&bar[XB_XCNT(j)]); sum += c; cnt += (c > 0u) ? 1u : 0u; mine = (j == x) ? c : mine; }
        if (sum == G) break;
        __builtin_amdgcn_s_sleep(1);
        if ((++sp & 255u) == 0u) { if (xb_ld(&bar[XB_TMO])) break; if (sp > XB_SPIN_CAP) { atomicAdd(&bar[XB_TMO], 1u); break; } }
    }
    nloc = mine > 0u ? mine : 1u; nx = cnt > 0u ? cnt : 1u;
}
DI void xcd_barrier(const XcdBarrier& b) {
    asm volatile("s_waitcnt vmcnt(0)" ::: "memory");
    __syncthreads();
    if (threadIdx.x == 0) {
        unsigned* bar = opaque_ptr(b.bar);
        __builtin_amdgcn_s_waitcnt(0);
        unsigned nloc = b.st[0], nx = b.st[1];
        if (nloc == 0u) { xcd_barrier_complete(bar, b.x, nloc, nx); b.st[0] = nloc; b.st[1] = nx; }
        const unsigned old = xb_add(&bar[XB_XSUB(b.x)], 1u);
        const unsigned gen = old / nloc;
        if (old + 1u == (gen + 1u) * nloc) {
            __builtin_amdgcn_fence(__ATOMIC_RELEASE, "agent");
            asm volatile("s_waitcnt vmcnt(0)" ::: "memory");
            const unsigned og = xb_add(&bar[XB_TOP], 1u);
            const unsigned tg = og / nx;
            if (og + 1u == (tg + 1u) * nx) xb_add(&bar[XB_TOPGEN], 1u);
            else XB_SPIN(xb_ld(&bar[XB_TOPGEN]) == tg, bar);
            __builtin_amdgcn_fence(__ATOMIC_ACQUIRE, "agent");
            xb_add(&bar[XB_XGEN(b.x)], 1u);
            asm volatile("s_waitcnt vmcnt(0)" ::: "memory");
        } else {
            XB_SPIN(xb_ld(&bar[XB_XGEN(b.x)]) == gen, bar);
            __builtin_amdgcn_fence(__ATOMIC_ACQUIRE, "agent");
            asm volatile("s_waitcnt vmcnt(0)" ::: "memory");
        }
    }
    __syncthreads();
}

struct Args { const float* in[28]; float* out; unsigned char* ws; int lo, hi; };
struct Ctx {
    LAS unsigned char* lds;
    int tid, lane, wave, G, bid;
    int gw, NGW;
    size_t gt, NGT;
};

DI void sincos_acc(float ang, float& s, float& c) {
    const double a = (double)ang; const double q = __builtin_rint(a * 0.63661977236758134308); const int n = (int)q;
    const float r = (float)(a - q * 1.57079632679489661923);
    const float r2 = r * r;
    const float sp = r + r * r2 * (-1.6666654611e-1f + r2 * (8.3321608736e-3f + r2 * -1.9515295891e-4f));
    const float cp = 1.0f - 0.5f * r2 + r2 * r2 * (4.166664568298827e-2f + r2 * (-1.388731625493765e-3f + r2 * 2.443315711809948e-5f));
    switch (n & 3) { case 0: s = sp; c = cp; break; case 1: s = cp; c = -sp; break; case 2: s = -sp; c = -cp; break; default: s = -cp; c = sp; break; }
}
DI void phase_init(const Ctx& C, const Args& A) {
    const f32x4* xp = (const f32x4*)A.in[0]; const f32x4* xs = (const f32x4*)A.in[1];
    f32x4* o = (f32x4*)A.out; u32x2* xb = (u32x2*)(A.ws + WS_XB);
    const size_t n4 = (size_t)T * D / 4, np4 = (size_t)8 * SEQ * D / 4;
    for (size_t i = C.gt; i < n4; i += C.NGT) { const f32x4 v = (i < np4) ? xp[i] : xs[i - np4]; o[i] = v; u32x2 w; w.x = pk2(v[0], v[1]); w.y = pk2(v[2], v[3]); xb[i] = w; }
    float* rn = (float*)(A.ws + WS_ROPE_N); float* rt = (float*)(A.ws + WS_ROPE_T);
    for (size_t i = C.gt; i < (size_t)SEQ * 128; i += C.NGT) {
        const int pos = (int)(i >> 7), k = (int)(i & 127);
        const float inv = (float)exp2(-(double)k * (13.287712379549449 / 128.0));
        const float ang = (float)pos * inv; float s, c; sincos_acc(ang, s, c);
        rn[i] = c; rn[(size_t)SEQ * 128 + i] = s;
        rt[(size_t)k * SEQ + pos] = c; rt[(size_t)128 * SEQ + (size_t)k * SEQ + pos] = s;
    }
}

DI void xpose_item(const float* W, int ldw, int c0, int K, bf16_t* WT, int drow0, LAS float* scr, int item, int nblk, int lane, int remap) {
    const int kb = item / nblk, nb = item % nblk, k0 = 64 * kb, n0 = 32 * nb;
#pragma unroll 8
    for (int i = 0; i < 32; ++i) { const int kk = 2 * i + (lane >> 5); scr[kk * 33 + (lane & 31)] = W[(size_t)(k0 + kk) * ldw + c0 + n0 + (lane & 31)]; }
    asm volatile("s_waitcnt lgkmcnt(0)" ::: "memory");
    const int c = lane & 7;
#pragma unroll
    for (int j = 0; j < 4; ++j) { const int n = (lane >> 3) + 8 * j; const LAS float* s = scr + (8 * c) * 33 + n;
        u32x4 o; o.x = pk2(s[0 * 33], s[1 * 33]); o.y = pk2(s[2 * 33], s[3 * 33]); o.z = pk2(s[4 * 33], s[5 * 33]); o.w = pk2(s[6 * 33], s[7 * 33]);
        const int nn = n0 + n, drow = remap ? 256 * (nn >> 7) + (nn & 127) + drow0 : drow0 + nn;
        *(u32x4*)(WT + (size_t)drow * K + k0 + 8 * c) = o; }
    asm volatile("s_waitcnt lgkmcnt(0)" ::: "memory");
}
struct XJob { const float* W; int ldw, c0, ncols, K; bf16_t* WT; int drow0; int remap; };
DI bool xpose_run(const Ctx& C, const XJob& j, int& base) {
    const int nblk = j.ncols / 32, items = (j.K / 64) * nblk;
    LAS float* scr = (LAS float*)(C.lds + C.wave * 16384);
    int it = (C.gw - (base % C.NGW) + C.NGW) % C.NGW;
    for (; it < items; it += C.NGW) xpose_item(j.W, j.ldw, j.c0, j.K, j.WT, j.drow0, scr, it, nblk, C.lane, j.remap);
    base += items; return true;
}
DI void phase_wprep(const Ctx& C, const Args& A, int l) {
    const int e = l >> 1; int base = 0;
    if (!(l & 1)) {
        XJob j0{A.in[2] + (size_t)e * D * AB_IN, AB_IN, 0, AB_IN, D, (bf16_t*)(A.ws + WE_IN), 0, 0}; xpose_run(C, j0, base);
        XJob j1{A.in[15] + (size_t)e * D * D, D, 0, D, D, (bf16_t*)(A.ws + WE_OUT), 0, 0}; xpose_run(C, j1, base);
        XJob j2{A.in[22] + (size_t)l * D * FF2, FF2, 0, D_FF, D, (bf16_t*)(A.ws + WE_UP), 0, 1}; xpose_run(C, j2, base);
        XJob j2u{A.in[22] + (size_t)l * D * FF2, FF2, D_FF, D_FF, D, (bf16_t*)(A.ws + WE_UP), 128, 1}; xpose_run(C, j2u, base);
        XJob j3{A.in[25] + (size_t)l * D_FF * D, D, 0, D, D_FF, (bf16_t*)(A.ws + WE_DN), 0, 0}; xpose_run(C, j3, base);
        const float* wup = A.in[5] + (size_t)e * 2 * 64 * A_W; const float* aup = A.in[7] + (size_t)e * 2 * 64 * A_W; const float* gup = A.in[8] + (size_t)e * 128 * A_W;
        bf16_t* lt = (bf16_t*)(A.ws + WE_LORA);
        for (size_t i = C.gt; i < (size_t)LORA_N * LORA_K; i += C.NGT) {
            const int row = (int)(i >> 8), kk = (int)(i & 255), type = row >> 10, c = row & 1023; float v = 0.f;
            if (type < 2) { if (kk < 64) v = wup[((size_t)type * 64 + kk) * A_W + c]; }
            else if (type < 4) { if (kk >= 64 && kk < 128) v = aup[((size_t)(type - 2) * 64 + (kk - 64)) * A_W + c]; }
            else { if (kk >= 128) v = gup[(size_t)(kk - 128) * A_W + c]; }
            lt[i] = (bf16_t)f2bf(v);
        }
    } else {
        const float* cin = A.in[16] + (size_t)e * D * C_IN; bf16_t* ct = (bf16_t*)(A.ws + WO_IN);
        XJob q{cin, C_IN, 0, 2048, D, ct, 0, 0}; xpose_run(C, q, base);
        XJob k{cin, C_IN, 2048, 2048, D, ct, 2048, 0}; xpose_run(C, k, base);
        XJob g{cin, C_IN, 8192, 4096, D, ct, 4096, 0}; xpose_run(C, g, base);
        XJob k2{cin, C_IN, 2048, 2048, D, ct, 8192, 0}; xpose_run(C, k2, base);
        XJob v{cin, C_IN, 4096, 4096, D, ct, 10240, 0}; xpose_run(C, v, base);
        XJob o{A.in[19] + (size_t)e * C_V * D, D, 0, D, C_V, (bf16_t*)(A.ws + WO_OUT), 0, 0}; xpose_run(C, o, base);
        XJob j2{A.in[22] + (size_t)l * D * FF2, FF2, 0, D_FF, D, (bf16_t*)(A.ws + WO_UP), 0, 1}; xpose_run(C, j2, base);
        XJob j2u{A.in[22] + (size_t)l * D * FF2, FF2, D_FF, D_FF, D, (bf16_t*)(A.ws + WO_UP), 128, 1}; xpose_run(C, j2u, base);
        XJob j3{A.in[25] + (size_t)l * D_FF * D, D, 0, D, D_FF, (bf16_t*)(A.ws + WO_DN), 0, 0}; xpose_run(C, j3, base);
    }
}

DI void phase_ln(const Ctx& C, const Args& A, int row0, int nrows, const float* g, const float* b) {
    for (int m = row0 + C.gw; m < row0 + nrows; m += C.NGW) {
        f32x4* xr = (f32x4*)(A.out + (size_t)m * D) + C.lane;
        f32x4 v[8]; float s = 0.f;
#pragma unroll
        for (int j = 0; j < 8; ++j) { v[j] = xr[64 * j]; s += (v[j][0] + v[j][1]) + (v[j][2] + v[j][3]); }
        const float mean = wave_sum(s) * (1.f / D); float s2 = 0.f;
#pragma unroll
        for (int j = 0; j < 8; ++j) { v[j] = v[j] - mean; s2 += (v[j][0] * v[j][0] + v[j][1] * v[j][1]) + (v[j][2] * v[j][2] + v[j][3] * v[j][3]); }
        const float rstd = 1.f / sqrtf(wave_sum(s2) * (1.f / D) + LN_EPS);
        u32x2* o8 = (u32x2*)((bf16_t*)(A.ws + WS_XB) + (size_t)m * D) + C.lane;
#pragma unroll
        for (int j = 0; j < 8; ++j) { const f32x4 gg = ((const f32x4*)g)[C.lane + 64 * j], bb = ((const f32x4*)b)[C.lane + 64 * j];
            const f32x4 y = v[j] * rstd * gg + bb; xr[64 * j] = y; u32x2 w; w.x = pk2(y[0], y[1]); w.y = pk2(y[2], y[3]); o8[64 * j] = w; }
    }
}

DI void phase_na(const Ctx& C, const Args& A, int e) {
    const bf16_t* HB = (const bf16_t*)(A.ws + WS_HB); bf16_t* YAB = (bf16_t*)(A.ws + WS_YAB);
    const float* rpb = A.in[14] + (size_t)e * 16 * 15 * 31;
    for (int task = C.gw; task < NSEQ * 16 * 64; task += C.NGW) {
        const int r = task & 63, h = (task >> 6) & 15, sq = task >> 10;
        const int c = C.lane;
        const int rs = min(max(r - 4, 0), 56), cs = min(max(c - 8, 0), 48);
        const size_t tq = (size_t)sq * SEQ + r * 64 + c;
        float q[64], o[64];
        { const u32x4* qp = (const u32x4*)(HB + tq * NB_COLS + h * 64);
#pragma unroll
          for (int j = 0; j < 8; ++j) { const u32x4 w = qp[j]; q[8 * j + 0] = bflo(w.x) * 0.125f; q[8 * j + 1] = bfhi(w.x) * 0.125f; q[8 * j + 2] = bflo(w.y) * 0.125f; q[8 * j + 3] = bfhi(w.y) * 0.125f;
              q[8 * j + 4] = bflo(w.z) * 0.125f; q[8 * j + 5] = bfhi(w.z) * 0.125f; q[8 * j + 6] = bflo(w.w) * 0.125f; q[8 * j + 7] = bfhi(w.w) * 0.125f; } }
#pragma unroll
        for (int j = 0; j < 64; ++j) o[j] = 0.f;
        float mx = -1e30f, l = 0.f;
        for (int i = 0; i < 8; ++i) {
            const float* brow = rpb + ((size_t)h * 15 + (rs + i - r + 7)) * 31 + (cs - c + 15);
            for (int jj = 0; jj < 16; ++jj) {
                const size_t tk = (size_t)sq * SEQ + (rs + i) * 64 + cs + jj;
                const u32x4* kp = (const u32x4*)(HB + tk * NB_COLS + 1024 + h * 64);
                float s = 0.f;
#pragma unroll
                for (int j = 0; j < 8; ++j) { const u32x4 w = kp[j];
                    s += q[8 * j + 0] * bflo(w.x) + q[8 * j + 1] * bfhi(w.x) + q[8 * j + 2] * bflo(w.y) + q[8 * j + 3] * bfhi(w.y) + q[8 * j + 4] * bflo(w.z) + q[8 * j + 5] * bfhi(w.z) + q[8 * j + 6] * bflo(w.w) + q[8 * j + 7] * bfhi(w.w); }
                s += brow[jj];
                const float mn = fmaxf(mx, s), sc = __expf(mx - mn), p = __expf(s - mn);
                l = l * sc + p; mx = mn;
                const u32x4* vp = (const u32x4*)(HB + tk * NB_COLS + 2048 + h * 64);
#pragma unroll
                for (int j = 0; j < 8; ++j) { const u32x4 w = vp[j];
                    o[8 * j + 0] = o[8 * j + 0] * sc + p * bflo(w.x); o[8 * j + 1] = o[8 * j + 1] * sc + p * bfhi(w.x); o[8 * j + 2] = o[8 * j + 2] * sc + p * bflo(w.y); o[8 * j + 3] = o[8 * j + 3] * sc + p * bfhi(w.y);
                    o[8 * j + 4] = o[8 * j + 4] * sc + p * bflo(w.z); o[8 * j + 5] = o[8 * j + 5] * sc + p * bfhi(w.z); o[8 * j + 6] = o[8 * j + 6] * sc + p * bflo(w.w); o[8 * j + 7] = o[8 * j + 7] * sc + p * bfhi(w.w); }
            }
        }
        const float il = 1.0f / l;
        u32x4* op = (u32x4*)(YAB + tq * D + 1024 + h * 64);
#pragma unroll
        for (int j = 0; j < 8; ++j) { u32x4 w; w.x = pk2(o[8 * j] * il, o[8 * j + 1] * il); w.y = pk2(o[8 * j + 2] * il, o[8 * j + 3] * il); w.z = pk2(o[8 * j + 4] * il, o[8 * j + 5] * il); w.w = pk2(o[8 * j + 6] * il, o[8 * j + 7] * il); op[j] = w; }
    }
}

DI void unpack8(const u32x4 w, float (&f)[8]) { f[0] = bflo(w.x); f[1] = bfhi(w.x); f[2] = bflo(w.y); f[3] = bfhi(w.y); f[4] = bflo(w.z); f[5] = bfhi(w.z); f[6] = bflo(w.w); f[7] = bfhi(w.w); }
DI void phase_conv_a(const Ctx& C, const Args& A, int e) {
    const bf16_t* HA = (const bf16_t*)(A.ws + WS_HA); bf16_t* RK = (bf16_t*)(A.ws + WS_HB); bf16_t* LIN = (bf16_t*)(A.ws + WS_LIN);
    const float* sh = A.in[3] + (size_t)e * 3 * A_COLS; const float* k_k = A.in[9] + (size_t)e * A_W; float* KKN = (float*)(A.ws + WS_KKN);
    constexpr int C8 = A_COLS / 8;
    for (size_t i = C.gt; i < (size_t)T * C8; i += C.NGT) {
        const int t = (int)(i / C8), c8 = (int)(i % C8), c = c8 * 8, pos = t & (SEQ - 1);
        float x0[8], x1[8], x2[8];
        const u32x4 z = (u32x4){0u, 0u, 0u, 0u};
        unpack8(pos > 0 ? *(const u32x4*)(HA + (size_t)(t - 1) * A_COLS + c) : z, x0);
        unpack8(*(const u32x4*)(HA + (size_t)t * A_COLS + c), x1);
        unpack8(pos < SEQ - 1 ? *(const u32x4*)(HA + (size_t)(t + 1) * A_COLS + c) : z, x2);
        float y[8];
#pragma unroll
        for (int j = 0; j < 8; ++j) y[j] = sh[c + j] * x0[j] + sh[A_COLS + c + j] * x1[j] + sh[2 * A_COLS + c + j] * x2[j];
        {
            float p = 0.f;
            if (c >= 1024 && c < 2048) {
#pragma unroll
                for (int j = 0; j < 8; ++j) { const float kb = bf2f((unsigned short)f2bf(y[j])) * k_k[c - 1024 + j]; p += kb * kb; } }
            p += __shfl_xor(p, 1); p += __shfl_xor(p, 2); p += __shfl_xor(p, 4);
            if (c >= 1024 && c < 2048 && (c8 & 7) == 0) KKN[(size_t)t * 16 + ((c - 1024) >> 6)] = 1.0f / fmaxf(sqrtf(p), 1e-12f);
        }
        if (c < 3072) { u32x4 w; w.x = pk2(y[0], y[1]); w.y = pk2(y[2], y[3]); w.z = pk2(y[4], y[5]); w.w = pk2(y[6], y[7]); *(u32x4*)(RK + (size_t)t * NB_COLS + c) = w; }
        else { const int cc = c - 3072;
#pragma unroll
            for (int j = 0; j < 8; ++j) { if (cc < 64) y[j] = tanhf(y[j]); else if (cc >= 128) y[j] = sigmoidf_(y[j]); }
            u32x4 w; w.x = pk2(y[0], y[1]); w.y = pk2(y[2], y[3]); w.z = pk2(y[4], y[5]); w.w = pk2(y[6], y[7]); *(u32x4*)(LIN + (size_t)t * LORA_K + cc) = w; }
    }
}

#define DPP_FMAC(acc, bvec, x, N) asm("v_fmac_f32_dpp %0, %1, %2 row_newbcast:" #N " row_mask:0xf bank_mask:0xf" : "+v"(acc) : "v"(bvec), "v"(x))
#define DPP_MUL(dst, bvec, x, N)  asm("v_mul_f32_dpp %0, %1, %2 row_newbcast:" #N " row_mask:0xf bank_mask:0xf" : "=v"(dst) : "v"(bvec), "v"(x))
DI float xrow_sum(float x) {
    float a = x, b = x;
    asm("s_nop 1\n\tv_permlane16_swap_b32 %0, %1" : "+v"(a), "+v"(b));
    const float s = a + b; float c = s, d = s;
    asm("s_nop 1\n\tv_permlane32_swap_b32 %0, %1" : "+v"(c), "+v"(d));
    return c + d;
}
template <int DIR> DI void scan_task(const Ctx& C, const Args& A, int e, int sq, int h, int wv) {
    constexpr int PD = 8;
    const int lane = C.lane, il = lane & 15;
    const size_t tb = (size_t)sq * SEQ;
    const bf16_t* rkp = (const bf16_t*)(A.ws + WS_HB) + tb * NB_COLS + h * 64;
    const unsigned short* ewp = (const unsigned short*)(A.ws + WS_EWA) + (size_t)DIR * T * A_W + tb * A_W + h * 64 + lane;
    const unsigned short* aap = (const unsigned short*)(A.ws + WS_EWA) + (size_t)(2 + DIR) * T * A_W + tb * A_W + h * 64 + lane;
    const float* knp = (const float*)(A.ws + WS_KKN) + tb * 16 + h;
    bf16_t* yo = (bf16_t*)(A.ws + (DIR ? WS_YBK : WS_YF)) + tb * A_W + h * 64 + 16 * wv + il;
    const float kk_c = (A.in[9] + (size_t)e * A_W)[h * 64 + lane], ka_c = (A.in[10] + (size_t)e * A_W)[h * 64 + lane];
    float S[16];
#pragma unroll
    for (int n = 0; n < 16; ++n) S[n] = 0.f;
    unsigned short pr[PD], pk[PD], pv[PD], pw[PD], pa[PD]; float pn[PD];
#define SCAN_T(st) ((size_t)(DIR ? (SEQ - 1 - (st)) : (st)))
#define SCAN_LOAD(slot, st) do { const size_t t_ = SCAN_T(st); pr[slot] = rkp[t_ * NB_COLS + lane]; pk[slot] = rkp[t_ * NB_COLS + 1024 + lane]; pv[slot] = rkp[t_ * NB_COLS + 2048 + 16 * wv + il]; \
        pw[slot] = ewp[t_ * A_W]; pa[slot] = aap[t_ * A_W]; pn[slot] = knp[t_ * 16]; } while (0)
#define SCAN_OPS(slot) do { const float k_ = bf2f(pk[slot]), a_ = h2f(pa[slot]); kk = k_ * kk_c * pn[slot]; w = __expf(-h2f(pw[slot])); ka = kk * a_; kd = k_ * (1.0f + (a_ - 1.0f) * ka_c); rr = bf2f(pr[slot]); vv = bf2f(pv[slot]); } while (0)
#pragma unroll
    for (int s = 0; s < PD; ++s) SCAN_LOAD(s, s);
    float kk, w, ka, kd, rr, vv;
    SCAN_OPS(0);
    for (int b = 0; b < SEQ / PD; ++b) {
#pragma unroll
        for (int s = 0; s < PD; ++s) {
            const int st = b * PD + s;
            asm volatile("s_nop 1" : "+v"(kk), "+v"(w), "+v"(ka), "+v"(kd), "+v"(rr));
            float sa0, sa1, sa2, sa3, y0, y1, y2, y3;
            DPP_MUL(sa0, kk, S[0], 0); DPP_MUL(sa1, kk, S[1], 1); DPP_MUL(sa2, kk, S[2], 2); DPP_MUL(sa3, kk, S[3], 3);
            DPP_FMAC(sa0, kk, S[4], 4); DPP_FMAC(sa1, kk, S[5], 5); DPP_FMAC(sa2, kk, S[6], 6); DPP_FMAC(sa3, kk, S[7], 7);
            DPP_FMAC(sa0, kk, S[8], 8); DPP_FMAC(sa1, kk, S[9], 9); DPP_FMAC(sa2, kk, S[10], 10); DPP_FMAC(sa3, kk, S[11], 11);
            DPP_FMAC(sa0, kk, S[12], 12); DPP_FMAC(sa1, kk, S[13], 13); DPP_FMAC(sa2, kk, S[14], 14); DPP_FMAC(sa3, kk, S[15], 15);
            if (DIR == 1) {
                DPP_MUL(y0, rr, S[0], 0); DPP_MUL(y1, rr, S[1], 1); DPP_MUL(y2, rr, S[2], 2); DPP_MUL(y3, rr, S[3], 3);
                DPP_FMAC(y0, rr, S[4], 4); DPP_FMAC(y1, rr, S[5], 5); DPP_FMAC(y2, rr, S[6], 6); DPP_FMAC(y3, rr, S[7], 7);
                DPP_FMAC(y0, rr, S[8], 8); DPP_FMAC(y1, rr, S[9], 9); DPP_FMAC(y2, rr, S[10], 10); DPP_FMAC(y3, rr, S[11], 11);
                DPP_FMAC(y0, rr, S[12], 12); DPP_FMAC(y1, rr, S[13], 13); DPP_FMAC(y2, rr, S[14], 14); DPP_FMAC(y3, rr, S[15], 15);
            }
            const float sa = -xrow_sum((sa0 + sa1) + (sa2 + sa3));
#define SCAN_UPD(n) { float t_; DPP_MUL(t_, kd, vv, n); DPP_FMAC(t_, ka, sa, n); DPP_FMAC(t_, w, S[n], n); S[n] = t_; }
            SCAN_UPD(0) SCAN_UPD(1) SCAN_UPD(2) SCAN_UPD(3) SCAN_UPD(4) SCAN_UPD(5) SCAN_UPD(6) SCAN_UPD(7)
            SCAN_UPD(8) SCAN_UPD(9) SCAN_UPD(10) SCAN_UPD(11) SCAN_UPD(12) SCAN_UPD(13) SCAN_UPD(14) SCAN_UPD(15)
#undef SCAN_UPD
            if (DIR == 0) {
                DPP_MUL(y0, rr, S[0], 0); DPP_MUL(y1, rr, S[1], 1); DPP_MUL(y2, rr, S[2], 2); DPP_MUL(y3, rr, S[3], 3);
                DPP_FMAC(y0, rr, S[4], 4); DPP_FMAC(y1, rr, S[5], 5); DPP_FMAC(y2, rr, S[6], 6); DPP_FMAC(y3, rr, S[7], 7);
                DPP_FMAC(y0, rr, S[8], 8); DPP_FMAC(y1, rr, S[9], 9); DPP_FMAC(y2, rr, S[10], 10); DPP_FMAC(y3, rr, S[11], 11);
                DPP_FMAC(y0, rr, S[12], 12); DPP_FMAC(y1, rr, S[13], 13); DPP_FMAC(y2, rr, S[14], 14); DPP_FMAC(y3, rr, S[15], 15);
            }
            const float y = xrow_sum((y0 + y1) + (y2 + y3));
            if (lane < 16) yo[SCAN_T(st) * A_W] = (bf16_t)f2bf(y);
            { const int sn = st + PD < SEQ ? st + PD : SEQ - 1; SCAN_LOAD(s, sn); }
            SCAN_OPS((s + 1) % PD);
        }
    }
#undef SCAN_T
#undef SCAN_LOAD
#undef SCAN_OPS
}
DI void phase_scan(const Ctx& C, const Args& A, int e) {
    for (int hp = C.bid; hp < NSEQ * 16; hp += C.G) {
        const int sq = hp >> 4, h = hp & 15, wv = C.wave & 3;
        if (C.wave < 4) scan_task<0>(C, A, e, sq, h, wv); else scan_task<1>(C, A, e, sq, h, wv);
    }
}

DI void phase_rwkv_post(const Ctx& C, const Args& A, int e) {
    const bf16_t* RK = (const bf16_t*)(A.ws + WS_HB); const unsigned short* AF = (const unsigned short*)(A.ws + WS_EWA) + (size_t)2 * T * A_W;
    const bf16_t* YF = (const bf16_t*)(A.ws + WS_YF); const bf16_t* YB = (const bf16_t*)(A.ws + WS_YBK); const bf16_t* GT = (const bf16_t*)(A.ws + WS_GATE);
    bf16_t* YAB = (bf16_t*)(A.ws + WS_YAB);
    const float* k_a = A.in[10] + (size_t)e * A_W; const float* r_k = A.in[11] + (size_t)e * A_W; const float* gg = A.in[12] + (size_t)e * A_W; const float* gb = A.in[13] + (size_t)e * A_W;
    for (int task = C.gw; task < T * 16; task += C.NGW) {
        const int t = task >> 4, h = task & 15, c = h * 64 + C.lane;
        const float y = bf2f(YF[(size_t)t * A_W + c]) + bf2f(YB[(size_t)t * A_W + c]);
        const float mu = wave_sum(y) * (1.f / 64.f); const float d = y - mu; const float var = wave_sum(d * d) * (1.f / 64.f);
        const float yn = d * (1.0f / sqrtf(var + A_GN_EPS)) * gg[c] + gb[c];
        const float r = bf2f(RK[(size_t)t * NB_COLS + c]), k = bf2f(RK[(size_t)t * NB_COLS + 1024 + c]), v = bf2f(RK[(size_t)t * NB_COLS + 2048 + c]);
        const float a = h2f(AF[(size_t)t * A_W + c]);
        const float kf = k * (1.0f + (a - 1.0f) * k_a[c]);
        const float bs = wave_sum(r * kf * r_k[c]);
        const float o = (yn + bs * v) * bf2f(GT[(size_t)t * A_W + c]);
        YAB[(size_t)t * D + c] = (bf16_t)f2bf(o);
    }
}

DI f32x2 gelu_pk(f32x2 v) {
    const f32x2 av = __builtin_elementwise_abs(v), d = av * 0.2316418882f + 1.0f;
    f32x2 t; t.x = __builtin_amdgcn_rcpf(d.x); t.y = __builtin_amdgcn_rcpf(d.y);
    f32x2 q = t * 0.5307027145f + (-0.7265760135f); q = q * t + 0.7107068705f; q = q * t + (-0.142248368f); q = q * t + 0.127414796f; q = q * t;
    const f32x2 s = (v * v) * (-0.72134752044f);
    f32x2 e; e.x = __builtin_amdgcn_exp2f(s.x); e.y = __builtin_amdgcn_exp2f(s.y);
    const f32x2 m = v * (q * e), r = v - m;
    f32x2 o; o.x = v.x < 0.f ? m.x : r.x; o.y = v.y < 0.f ? m.y : r.y; return o;
}
DI float gelu1(float v) { const f32x2 r = gelu_pk((f32x2){v, v}); return r.x; }
template <int CTRL> DI float dpp1(float v) { return __builtin_bit_cast(float, __builtin_amdgcn_update_dpp(0, __builtin_bit_cast(int, v), CTRL, 0xf, 0xf, false)); }
template <int CTRL> DI f32x4 dpp4(f32x4 v) { f32x4 r; r.x = dpp1<CTRL>(v.x); r.y = dpp1<CTRL>(v.y); r.z = dpp1<CTRL>(v.z); r.w = dpp1<CTRL>(v.w); return r; }
struct EpiFfnAct {
    static constexpr bool PERM = true;
    bf16_t* ACT; float* EDGE; const float* cw; const float* cb; LAS float* eb;
    DI void operator()(AccRef acc, const pg8::Unit& u, int wr, int wc, int fr, int fq) const {
        const int j0 = wc * 32 + 8 * fq, cg = u.pn * 128 + j0;
#pragma unroll
        for (int ai = 0; ai < 2; ++ai) { const int slab = 2 * ai + wr + 1;
            if (fr == 0) { *(LAS f32x4*)(eb + (slab * 2 + 0) * 128 + j0) = acc[ai][0][0][0]; *(LAS f32x4*)(eb + (slab * 2 + 0) * 128 + j0 + 4) = acc[ai][0][0][1]; }
            if (fr == 15) { *(LAS f32x4*)(eb + (slab * 2 + 1) * 128 + j0) = acc[ai][0][3][0]; *(LAS f32x4*)(eb + (slab * 2 + 1) * 128 + j0 + 4) = acc[ai][0][3][1]; } }
        { float* ed = EDGE + ((size_t)(u.pm * FF_NT + u.pn) * 6) * 128 + j0;
          if (wr == 0 && fr < 2) { *(f32x4*)(ed + fr * 128) = acc[0][0][0][0]; *(f32x4*)(ed + fr * 128 + 4) = acc[0][0][0][1]; if (fr == 0) { *(f32x4*)(ed + 4 * 128) = acc[0][1][0][0]; *(f32x4*)(ed + 4 * 128 + 4) = acc[0][1][0][1]; } }
          if (wr == 1 && fr >= 14) { *(f32x4*)(ed + (fr - 12) * 128) = acc[1][0][3][0]; *(f32x4*)(ed + (fr - 12) * 128 + 4) = acc[1][0][3][1]; if (fr == 15) { *(f32x4*)(ed + 5 * 128) = acc[1][1][3][0]; *(f32x4*)(ed + 5 * 128 + 4) = acc[1][1][3][1]; } } }
        const f32x4 w00 = *(const f32x4*)(cw + cg), w01 = *(const f32x4*)(cw + cg + 4), w10 = *(const f32x4*)(cw + D_FF + cg), w11 = *(const f32x4*)(cw + D_FF + cg + 4);
        const f32x4 w20 = *(const f32x4*)(cw + 2 * D_FF + cg), w21 = *(const f32x4*)(cw + 2 * D_FF + cg + 4), b0 = *(const f32x4*)(cb + cg), b1 = *(const f32x4*)(cb + cg + 4);
        asm volatile("s_waitcnt lgkmcnt(0)" ::: "memory"); __builtin_amdgcn_s_barrier(); asm volatile("" ::: "memory");
#pragma unroll
        for (int ai = 0; ai < 2; ++ai) { const int slab = 2 * ai + wr + 1;
            const f32x4 pl0 = *(const LAS f32x4*)(eb + ((slab - 1) * 2 + 1) * 128 + j0), pl1 = *(const LAS f32x4*)(eb + ((slab - 1) * 2 + 1) * 128 + j0 + 4);
            const f32x4 nl0 = *(const LAS f32x4*)(eb + ((slab + 1) * 2 + 0) * 128 + j0), nl1 = *(const LAS f32x4*)(eb + ((slab + 1) * 2 + 0) * 128 + j0 + 4);
#pragma unroll
            for (int m = 0; m < 4; ++m) {
                const f32x4 g0 = acc[ai][0][m][0], g1 = acc[ai][0][m][1];
                f32x4 p0 = dpp4<0x121>(g0), p1 = dpp4<0x121>(g1), n0 = dpp4<0x12F>(g0), n1 = dpp4<0x12F>(g1);
                if (m > 0) { const f32x4 q0 = dpp4<0x121>(acc[ai][0][m > 0 ? m - 1 : 0][0]), q1 = dpp4<0x121>(acc[ai][0][m > 0 ? m - 1 : 0][1]); if (fr == 0) { p0 = q0; p1 = q1; } }
                else if (fr == 0) { p0 = pl0; p1 = pl1; }
                if (m < 3) { const f32x4 q0 = dpp4<0x12F>(acc[ai][0][m < 3 ? m + 1 : 3][0]), q1 = dpp4<0x12F>(acc[ai][0][m < 3 ? m + 1 : 3][1]); if (fr == 15) { n0 = q0; n1 = q1; } }
                else if (fr == 15) { n0 = nl0; n1 = nl1; }
                f32x4 x0 = w00 * p0 + w10 * g0 + w20 * n0 + b0, x1 = w01 * p1 + w11 * g1 + w21 * n1 + b1;
                const f32x2 a = gelu_pk((f32x2){x0[0], x0[1]}), b = gelu_pk((f32x2){x0[2], x0[3]}), c = gelu_pk((f32x2){x1[0], x1[1]}), d = gelu_pk((f32x2){x1[2], x1[3]});
                x0 = (f32x4){a.x, a.y, b.x, b.y} * acc[ai][1][m][0]; x1 = (f32x4){c.x, c.y, d.x, d.y} * acc[ai][1][m][1];
                *(u32x4*)(ACT + (size_t)(u.pm * 256 + ai * 128 + wr * 64 + m * 16 + fr) * D_FF + cg) = pack8(x0, x1);
                __builtin_amdgcn_sched_barrier(0);
            } }
    }
};
DI void phase_ffn_fix(const Ctx& C, const Args& A, int l) {
    const float* ED = (const float*)(A.ws + WS_EDGE); bf16_t* ACT = (bf16_t*)(A.ws + WS_ACT);
    const float* cw = A.in[23] + (size_t)l * 3 * D_FF; const float* cb = A.in[24] + (size_t)l * D_FF;
    const size_t n = (size_t)(T / 256) * FF_NT * 2 * 128;
    for (size_t i = C.gt; i < n; i += C.NGT) {
        const int j = (int)(i & 127), which = (int)((i >> 7) & 1); const int tile = (int)(i >> 8), pn = tile % FF_NT, pm = tile / FF_NT, c = pn * 128 + j;
        const float* e = ED + (size_t)tile * 6 * 128 + j;
        float pv, cv, nv, up;
        if (which == 0) { pv = (pm & 15) ? ED[((size_t)(tile - FF_NT) * 6 + 3) * 128 + j] : 0.f; cv = e[0]; nv = e[128]; up = e[4 * 128]; }
        else { pv = e[2 * 128]; cv = e[3 * 128]; nv = ((pm & 15) != 15) ? ED[((size_t)(tile + FF_NT) * 6 + 0) * 128 + j] : 0.f; up = e[5 * 128]; }
        const float g = cw[c] * pv + cw[D_FF + c] * cv + cw[2 * D_FF + c] * nv + cb[c];
        ACT[(size_t)(pm * 256 + (which ? 255 : 0)) * D_FF + c] = (bf16_t)f2bf(gelu1(g) * up);
    }
}

DI void phase_ret_scan(const Ctx& C, const Args& A) {
    const float* KVF = (const float*)(A.ws + WS_KVF); const float* KVB = (const float*)(A.ws + WS_KVB); bf16_t* BC = (bf16_t*)(A.ws + WS_BCAT);
    constexpr size_t PER = (size_t)512 * 256 / 4;
    for (size_t i = C.gt; i < (size_t)OG_SEQ * 8 * PER; i += C.NGT) {
        const int sh = (int)(i / PER), h = sh & 7; const size_t rem = i % PER; const int dv = (int)(rem >> 6), dk = (int)(rem & 63) * 4;
        const float gC = exp2f(256.0f * l2gamma(h));
        f32x4 f = (f32x4){0.f, 0.f, 0.f, 0.f};
        for (int n = 0; n < 16; ++n) { const size_t item = (size_t)sh * 16 + n;
            u32x2 w; w.x = pk2(f[0], f[1]); w.y = pk2(f[2], f[3]); *(u32x2*)(BC + (item * 512 + dv) * CATK + 256 + dk) = w;
            f = f * gC + *(const f32x4*)(KVF + (item * 512 + dv) * 256 + dk); }
        f = (f32x4){0.f, 0.f, 0.f, 0.f};
        for (int n = 15; n >= 0; --n) { const size_t item = (size_t)sh * 16 + n;
            u32x2 w; w.x = pk2(f[0], f[1]); w.y = pk2(f[2], f[3]); *(u32x2*)(BC + (item * 512 + dv) * CATK + 512 + dk) = w;
            f = f * gC + *(const f32x4*)(KVB + (item * 512 + dv) * 256 + dk); }
    }
}

DI void phase_ret_post(const Ctx& C, const Args& A, int e) {
    const float* Y = (const float*)(A.ws + WS_Y); const bf16_t* GS = (const bf16_t*)(A.ws + WS_GS); bf16_t* OB = (bf16_t*)(A.ws + WS_OB);
    const float* gg = A.in[17] + (size_t)e * C_V; const float* gb = A.in[18] + (size_t)e * C_V;
    for (int task = C.gw; task < OG_T * 8; task += C.NGW) {
        const int t = task >> 3, h = task & 7; const size_t off = (size_t)t * C_V + h * 512 + C.lane * 8;
        const f32x4 a = *(const f32x4*)(Y + off), b = *(const f32x4*)(Y + off + 4);
        const float mu = wave_sum((a[0] + a[1]) + (a[2] + a[3]) + (b[0] + b[1]) + (b[2] + b[3])) * (1.f / 512.f);
        const f32x4 da = a - mu, db = b - mu;
        const float var = wave_sum((da[0] * da[0] + da[1] * da[1]) + (da[2] * da[2] + da[3] * da[3]) + (db[0] * db[0] + db[1] * db[1]) + (db[2] * db[2] + db[3] * db[3])) * (1.f / 512.f);
        const float rs = 1.0f / sqrtf(var + LN_EPS);
        const int cc = h * 512 + C.lane * 8;
        const f32x4 g0 = *(const f32x4*)(gg + cc), g1 = *(const f32x4*)(gg + cc + 4), b0 = *(const f32x4*)(gb + cc), b1 = *(const f32x4*)(gb + cc + 4);
        float gs[8]; unpack8(*(const u32x4*)(GS + off), gs);
        const f32x4 o0 = (da * rs * g0 + b0), o1 = (db * rs * g1 + b1);
        u32x4 w; w.x = pk2(o0[0] * gs[0], o0[1] * gs[1]); w.y = pk2(o0[2] * gs[2], o0[3] * gs[3]); w.z = pk2(o1[0] * gs[4], o1[1] * gs[5]); w.w = pk2(o1[2] * gs[6], o1[3] * gs[7]);
        *(u32x4*)(OB + off) = w;
    }
}

DI bool step_ctx(Ctx& C, const Ctx& B) {
    int bid = B.bid, G = B.G, tid = B.tid;
    asm volatile("" : "+s"(bid), "+s"(G), "+v"(tid));
    C.lds = B.lds; C.tid = tid; C.lane = tid & 63; C.wave = __builtin_amdgcn_readfirstlane(tid >> 6); C.G = G; C.bid = bid;
    C.gw = bid * NWAVES + C.wave; C.NGW = G * NWAVES; C.gt = (size_t)bid * (NWAVES * 64) + tid; C.NGT = (size_t)G * NWAVES * 64;
    return true;
}
constexpr int N_STEPS = 1 + 2 * (1 + 8 + 4) + 2 * (1 + 7 * OG_N + 4);
__global__ void __launch_bounds__(NWAVES * 64, 2) mk_fwd(Args args) {
    extern __shared__ __attribute__((aligned(16))) unsigned char lds_raw[];
    Ctx C;
    C.lds = (LAS unsigned char*)lds_raw;
    C.tid = threadIdx.x; C.lane = C.tid & 63; C.wave = __builtin_amdgcn_readfirstlane(C.tid >> 6);
    C.G = gridDim.x; C.bid = blockIdx.x;
    C.gw = C.bid * NWAVES + C.wave; C.NGW = C.G * NWAVES;
    C.gt = (size_t)C.bid * (NWAVES * 64) + C.tid; C.NGT = (size_t)C.G * NWAVES * 64;
    volatile LAS unsigned* MISC = (volatile LAS unsigned*)(C.lds + MISC_OFF);
    for (int u = C.tid; u < (LDS_BYTES - LDSCTL_OFF) / 4; u += NWAVES * 64) ((LAS unsigned*)(C.lds + LDSCTL_OFF))[u] = 0u;
    __syncthreads();
    const int lo = args.lo, hi = args.hi;
    unsigned* barw = (unsigned*)(args.ws + WS_CTL) + CW_BAR;
    XcdBarrier bar; bar.bar = barw; bar.x = 0; bar.st = MISC + 8;
    if (hi - lo > 1) bar = xcd_barrier_post(barw, MISC + 8);
    LAS unsigned char* ring = C.lds;
    const Ctx Cb = C;
    int step = 0;
#define STEP_IF(kind) if (step >= lo && step < hi) for (int rep_ = 0; rep_ < 1 + (int)((PROBE_REP_MASK >> (kind)) & 1u); ++rep_) if (unsigned char* ws = opaque_ptr(args.ws)) if (step_ctx(C, Cb))
#define STEP_END do { if (step >= lo && step + 1 < hi) xcd_barrier(bar); ++step; } while (0)

    STEP_IF(0) { phase_init(C, args); } STEP_END;
    for (int l = 0; l < DEPTH; ++l) {
        const int e = l >> 1;
        STEP_IF(1) { phase_wprep(C, args, l); } STEP_END;
        if (!(l & 1)) {
            STEP_IF(2) {
                pg8::FlatOrder S; S.init(ws + WS_XB, ws + WE_IN, D, D, T, AB_IN, C.G, C.bid);
                EpiBf16Split E{(bf16_t*)(ws + WS_HA), A_COLS, (bf16_t*)(ws + WS_HB), NB_COLS, A_COLS / 256};
                pg8::gemm_phase(ring, pg8::Gemm{D, D, D}, S, E, C.tid);
            } STEP_END;
            STEP_IF(3) { phase_na(C, args, e); } STEP_END;
            STEP_IF(4) { phase_conv_a(C, args, e); } STEP_END;
            STEP_IF(5) {
                pg8::FlatOrder S; S.init(ws + WS_LIN, ws + WE_LORA, LORA_K, LORA_K, T, LORA_N, C.G, C.bid);
                EpiLora E{(unsigned short*)(ws + WS_EWA), (unsigned short*)(ws + WS_GATE), args.in[4] + (size_t)e * 2 * A_W, args.in[6] + (size_t)e * 2 * A_W};
                pg8::gemm_phase(ring, pg8::Gemm{LORA_K, LORA_K, LORA_K}, S, E, C.tid);
            } STEP_END;
            STEP_IF(6) { phase_scan(C, args, e); } STEP_END;
            STEP_IF(7) { phase_rwkv_post(C, args, e); } STEP_END;
            STEP_IF(8) {
                pg8::FlatOrder S; S.init(ws + WS_YAB, ws + WE_OUT, D, D, T, D, C.G, C.bid);
                EpiResF32 E{args.out, D, DN_ALPHA};
                pg8::gemm_phase(ring, pg8::Gemm{D, D, D}, S, E, C.tid);
            } STEP_END;
            STEP_IF(9) { phase_ln(C, args, 0, T, args.in[20] + (size_t)l * D, args.in[21] + (size_t)l * D); } STEP_END;
        } else {
            for (int g = 0; g < OG_N; ++g) {
                const size_t row0 = (size_t)g * OG_T;
                STEP_IF(10) {
                    { pg8::FlatOrder S; S.init(ws + WS_XB + row0 * D * 2, ws + WO_IN, D, D, OG_T, 8192, C.G, C.bid);
                      EpiO1a E{(bf16_t*)(ws + WS_QN), (bf16_t*)(ws + WS_KN), (bf16_t*)(ws + WS_GS), (bf16_t*)(ws + WS_ACAT), (const float*)(ws + WS_ROPE_N)};
                      pg8::gemm_phase(ring, pg8::Gemm{D, D, D}, S, E, C.tid); }
                    { pg8::FlatOrder S; S.init(ws + WO_IN + (size_t)8192 * D * 2, ws + WS_XB + row0 * D * 2, D, D, 6144, OG_T, C.G, C.bid);
                      EpiO1b E{(bf16_t*)(ws + WS_KTF), (bf16_t*)(ws + WS_KTB), (bf16_t*)(ws + WS_BCAT), (const float*)(ws + WS_ROPE_T)};
                      pg8::gemm_phase(ring, pg8::Gemm{D, D, D}, S, E, C.tid); }
                } STEP_END;
                STEP_IF(11) {
                    { RetOrder<0> S{(const char*)(ws + WS_QN), (const char*)(ws + WS_KN), C.G, C.bid}; EpiO2 E{(bf16_t*)(ws + WS_ACAT)};
                      pg8::gemm_phase(ring, pg8::Gemm{C_QK, C_QK, 256}, S, E, C.tid); }
                    { RetOrder<1> S{(const char*)(ws + WS_BCAT), (const char*)(ws + WS_KTF), C.G, C.bid}; EpiKV E{(float*)(ws + WS_KVF)};
                      pg8::gemm_phase(ring, pg8::Gemm{CATK, OG_T, 256}, S, E, C.tid); }
                    { RetOrder<1> S{(const char*)(ws + WS_BCAT), (const char*)(ws + WS_KTB), C.G, C.bid}; EpiKV E{(float*)(ws + WS_KVB)};
                      pg8::gemm_phase(ring, pg8::Gemm{CATK, OG_T, 256}, S, E, C.tid); }
                } STEP_END;
                STEP_IF(12) { phase_ret_scan(C, args); } STEP_END;
                STEP_IF(13) { RetOrder<2> S{(const char*)(ws + WS_ACAT), (const char*)(ws + WS_BCAT), C.G, C.bid}; EpiY E{(float*)(ws + WS_Y)};
                          pg8::gemm_phase(ring, pg8::Gemm{CATK, CATK, CATK}, S, E, C.tid); } STEP_END;
                STEP_IF(14) { phase_ret_post(C, args, e); } STEP_END;
                STEP_IF(15) { pg8::FlatOrder S; S.init(ws + WS_OB, ws + WO_OUT, C_V, C_V, OG_T, D, C.G, C.bid);
                          EpiResF32 E{args.out + row0 * D, D, DN_ALPHA};
                          pg8::gemm_phase(ring, pg8::Gemm{C_V, C_V, C_V}, S, E, C.tid); } STEP_END;
                STEP_IF(9) { phase_ln(C, args, (int)row0, OG_T, args.in[20] + (size_t)l * D, args.in[21] + (size_t)l * D); } STEP_END;
            }
        }
        {
            const size_t wup = (l & 1) ? WO_UP : WE_UP, wdn = (l & 1) ? WO_DN : WE_DN;
            STEP_IF(16) { pg8::FlatOrder S; S.init(ws + WS_XB, ws + wup, D, D, T, FF2, C.G, C.bid);
                      EpiFfnAct E{(bf16_t*)(ws + WS_ACT), (float*)(ws + WS_EDGE), args.in[23] + (size_t)l * 3 * D_FF, args.in[24] + (size_t)l * D_FF, (LAS float*)(C.lds + EB_OFF)};
                      pg8::gemm_phase(ring, pg8::Gemm{D, D, D}, S, E, C.tid); } STEP_END;
            STEP_IF(17) { phase_ffn_fix(C, args, l); } STEP_END;
            STEP_IF(18) { pg8::FlatOrder S; S.init(ws + WS_ACT, ws + wdn, D_FF, D_FF, T, D, C.G, C.bid);
                      EpiResF32 E{args.out, D, DN_ALPHA};
                      pg8::gemm_phase(ring, pg8::Gemm{D_FF, D_FF, D_FF}, S, E, C.tid); } STEP_END;
            STEP_IF(9) { phase_ln(C, args, 0, T, args.in[26] + (size_t)l * D, args.in[27] + (size_t)l * D); } STEP_END;
        }
    }
#undef STEP_IF
#undef STEP_END
}

extern "C" void kernel_launch(void* const* d_in, const int* in_sizes, int n_in, void* d_out, int out_size, void* d_ws, size_t ws_size, hipStream_t stream) {
    static int grid = 0;
    if (grid == 0) {
        if (n_in != 28 || out_size != T * D || ws_size < WS_NEED) { fprintf(stderr, "kernel_launch: unexpected shapes: n_in %d out %d ws %zu (need %zu)\n", n_in, out_size, ws_size, (size_t)WS_NEED); grid = -1; return; }
        int dev = 0, cus = 0, per_cu = 0;
        if (hipGetDevice(&dev) != hipSuccess || hipDeviceGetAttribute(&cus, hipDeviceAttributeMultiprocessorCount, dev) != hipSuccess) { grid = -1; return; }
        if (hipFuncSetAttribute((const void*)mk_fwd, hipFuncAttributeMaxDynamicSharedMemorySize, LDS_BYTES) != hipSuccess) { fprintf(stderr, "kernel_launch: hipFuncSetAttribute failed\n"); grid = -1; return; }
        if (hipOccupancyMaxActiveBlocksPerMultiprocessor(&per_cu, (const void*)mk_fwd, NWAVES * 64, LDS_BYTES) != hipSuccess || per_cu < 1) fprintf(stderr, "kernel_launch: occupancy query says %d\n", per_cu);
        (void)hipGetLastError();
        grid = cus;
    }
    if (grid < 0) return;
    (void)in_sizes;
    hipMemsetAsync((char*)d_ws + WS_CTL, 0, CTL_ZERO_BYTES, stream);
    Args a{};
    for (int i = 0; i < 28; ++i) a.in[i] = (const float*)d_in[i];
    a.out = (float*)d_out; a.ws = (unsigned char*)d_ws;
#if MK_MULTI_LAUNCH
    for (int s = 0; s < N_STEPS; ++s) { a.lo = s; a.hi = s + 1; hipLaunchKernelGGL(mk_fwd, dim3(grid), dim3(NWAVES * 64), LDS_BYTES, stream, a); }
#else
    a.lo = 0; a.hi = N_STEPS;
    hipLaunchKernelGGL(mk_fwd, dim3(grid), dim3(NWAVES * 64), LDS_BYTES, stream, a);
#endif
}
```

```cpp
#include <hip/hip_runtime.h>
#include <cstdio>
#include <cstdint>

#ifndef PROBE_REP_MASK
#define PROBE_REP_MASK 0u
#endif
#ifndef MK_MULTI_LAUNCH
#define MK_MULTI_LAUNCH 0
#endif

#define GAS __attribute__((address_space(1)))
#define LAS __attribute__((address_space(3)))
typedef unsigned short bf16_t;
typedef short bf16x8 __attribute__((ext_vector_type(8)));
typedef float f32x4 __attribute__((ext_vector_type(4)));
typedef float f32x2 __attribute__((ext_vector_type(2)));
typedef unsigned u32x4 __attribute__((ext_vector_type(4)));
typedef unsigned u32x2 __attribute__((ext_vector_type(2)));
typedef GAS unsigned gu32;
#define RLX_AGENT __ATOMIC_RELAXED, __HIP_MEMORY_SCOPE_AGENT
#define DI __device__ __forceinline__

constexpr int D = 2048, SEQ = 4096, NSEQ = 12, T = NSEQ * SEQ;
constexpr int A_W = 1024, A_COLS = 3328, AB_IN = 6400, B_W = 1024, NB_COLS = 3072;
constexpr int C_QK = 2048, C_V = 4096, C_IN = 12288;
constexpr int D_FF = 5504, FF2 = 11008;
constexpr int DEPTH = 4;
constexpr float DN_ALPHA = 1.6817928305074290f;
constexpr float LN_EPS = 1e-5f, A_GN_EPS = 64e-5f;
constexpr int GRID_W = 64;
constexpr int LORA_K = 256, LORA_N = 5120;
constexpr int OG_SEQ = 2, OG_T = OG_SEQ * SEQ, OG_N = NSEQ / OG_SEQ, RC = 256, RNC = SEQ / RC, OG_ITEMS = OG_SEQ * 8 * RNC;
constexpr int CATK = 768;

constexpr size_t MiB = 1u << 20;
constexpr size_t WS_CTL = 0, CTL_ZERO_BYTES = 1 * MiB;
constexpr size_t WS_ROPE_N = 1 * MiB;
constexpr size_t WS_ROPE_T = 5 * MiB;
constexpr size_t WS_W = 9 * MiB;
constexpr size_t WE_IN = WS_W, WE_OUT = WE_IN + (size_t)AB_IN * D * 2, WE_UP = WE_OUT + (size_t)D * D * 2, WE_DN = WE_UP + (size_t)FF2 * D * 2, WE_LORA = WE_DN + (size_t)D * D_FF * 2, WE_END = WE_LORA + (size_t)LORA_N * LORA_K * 2;
constexpr int CIN_ROWS = 14336;
constexpr size_t WO_IN = WS_W, WO_OUT = WO_IN + (size_t)CIN_ROWS * D * 2, WO_UP = WO_OUT + (size_t)D * C_V * 2, WO_DN = WO_UP + (size_t)FF2 * D * 2, WO_END = WO_DN + (size_t)D * D_FF * 2;
constexpr size_t WS_XB = 146 * MiB;
constexpr size_t WS_POOL = 338 * MiB;
static_assert(WE_END <= WS_XB && WO_END <= WS_XB, "weights region");
constexpr size_t WS_YAB = WS_XB;
constexpr size_t WS_HA = WS_POOL;
constexpr size_t WS_HB = WS_HA + (size_t)T * A_COLS * 2;
constexpr size_t WS_VT = WS_HB + (size_t)T * 2048 * 2;
constexpr size_t WS_EWA = WS_HB + (size_t)T * NB_COLS * 2;
constexpr size_t WS_EWA_END = WS_EWA + (size_t)4 * T * A_W * 2;
constexpr size_t WS_LIN = WS_EWA_END;
constexpr size_t WS_GATE = WS_HA;
constexpr size_t WS_YF = WS_HA + (size_t)T * A_W * 2;
constexpr size_t WS_YBK = WS_YF + (size_t)T * A_W * 2;
constexpr size_t WS_KKN = WS_LIN + (size_t)T * LORA_K * 2;
constexpr size_t WS_EVEN_END = WS_KKN + (size_t)T * 16 * 4;
constexpr int FF_NT = D_FF / 128;
constexpr size_t WS_ACT = WS_POOL;
constexpr size_t WS_EDGE = WS_ACT + (size_t)T * D_FF * 2;
constexpr size_t WS_FFN_END = WS_EDGE + (size_t)(T / 256) * FF_NT * 6 * 128 * 4;
constexpr size_t WS_QN = WS_POOL;
constexpr size_t WS_KN = WS_QN + (size_t)OG_T * C_QK * 2;
constexpr size_t WS_GS = WS_KN + (size_t)OG_T * C_QK * 2;
constexpr size_t WS_ACAT = WS_GS + (size_t)OG_T * C_V * 2;
constexpr size_t WS_BCAT = WS_ACAT + (size_t)OG_ITEMS * 256 * CATK * 2;
constexpr size_t WS_KTF = WS_BCAT + (size_t)OG_ITEMS * 512 * CATK * 2;
constexpr size_t WS_KTB = WS_KTF + (size_t)C_QK * OG_T * 2;
constexpr size_t WS_KVF = WS_KTB + (size_t)C_QK * OG_T * 2;
constexpr size_t WS_KVB = WS_KVF + (size_t)OG_ITEMS * 512 * 256 * 4;
constexpr size_t WS_Y = WS_KVB + (size_t)OG_ITEMS * 512 * 256 * 4;
constexpr size_t WS_OB = WS_Y + (size_t)OG_T * C_V * 4;
constexpr size_t WS_ODD_END = WS_OB + (size_t)OG_T * C_V * 2;
constexpr size_t WS_NEED = 1376 * MiB;
static_assert(WS_EVEN_END <= WS_NEED && WS_FFN_END <= WS_NEED && WS_ODD_END <= WS_NEED, "d_ws map");
constexpr int CW_TMO = 0, CW_BAR = 4096;

constexpr int RING_BYTES = 131072;
constexpr int LDSCTL_OFF = RING_BYTES, MISC_OFF = LDSCTL_OFF + 320, EB_OFF = LDSCTL_OFF + 512;
constexpr int LDS_BYTES = 147456;
constexpr int NWAVES = 8;

DI unsigned f2bf(float f) { unsigned u = __builtin_bit_cast(unsigned, f); return (u + 0x7fffu + ((u >> 16) & 1u)) >> 16; }
DI unsigned pk2(float lo, float hi) { return f2bf(lo) | (f2bf(hi) << 16); }
DI float bf2f(unsigned short b) { return __builtin_bit_cast(float, ((unsigned)b) << 16); }
DI float bflo(unsigned w) { return __builtin_bit_cast(float, w << 16); }
DI float bfhi(unsigned w) { return __builtin_bit_cast(float, w & 0xffff0000u); }
DI unsigned cvt_pk_bf16(float lo, float hi) { unsigned r; asm volatile("v_cvt_pk_bf16_f32 %0, %1, %2" : "=v"(r) : "v"(lo), "v"(hi)); return r; }
DI unsigned pk2h(float lo, float hi) { typedef _Float16 h2 __attribute__((ext_vector_type(2))); h2 v; v.x = (_Float16)lo; v.y = (_Float16)hi; return __builtin_bit_cast(unsigned, v); }
DI float h2f(unsigned short h) { return (float)__builtin_bit_cast(_Float16, h); }
DI float wave_sum(float v) {
#pragma unroll
    for (int o = 1; o < 64; o <<= 1) v += __shfl_xor(v, o);
    return v;
}
template <class P> DI P* opaque_ptr(P* p) { asm volatile("" : "+s"(p)); return p; }
DI float sigmoidf_(float x) { return 1.0f / (1.0f + __expf(-x)); }

namespace pg8 {
constexpr int BM = 256, BK = 64, HALF = 128, HTB = HALF * BK * 2, STAGE_BYTES = 8 * HTB, NXCD = 8, WGM = 8;
DI int lds_byte(int r, int c) { const int st = (r >> 4) * 2 + (c >> 5), rr = r & 15, cc = c & 31, ob = rr * 64 + cc * 2; return st * 1024 + (ob ^ (((ob >> 9) & 1) << 5)); }
DI void stage_rc(int b, int& R, int& C) { const int st = b / 1024, sb = b % 1024, swz = sb ^ (((sb >> 9) & 1) << 5); R = (st >> 1) * 16 + swz / 64; C = (st & 1) * 32 + (swz % 64) / 2; }
DI int perm32(int rho) { const int n = rho >> 4, i = rho & 15; return 8 * (i >> 2) + 4 * n + (i & 3); }

struct Unit { int pm, pn, item; const char* a; const char* b; };
struct Gemm { int lda, ldb, K; };

struct FlatOrder {
    const char* A; const char* Bt; int lda, ldb; int nM, nN, nwg, G, c;
    DI void init(const void* A_, const void* Bt_, int lda_, int ldb_, int M, int N, int G_, int c_) { A = (const char*)A_; Bt = (const char*)Bt_; lda = lda_; ldb = ldb_; nM = M / BM; nN = N / BM; nwg = nM * nN; G = G_; c = c_; }
    DI bool next(int i, Unit& u) const {
        const long L = (long)i * G + c; if (L >= nwg) return false;
        int wgid = (int)L; { const int q = nwg / NXCD, r = nwg % NXCD, xcd = wgid % NXCD, off = wgid / NXCD; wgid = (xcd < r ? xcd * (q + 1) : r * (q + 1) + (xcd - r) * q) + off; }
        const int nig = WGM * nN, gid = wgid / nig, fm = gid * WGM, gsz = (nM - fm) < WGM ? (nM - fm) : WGM;
        u.pm = fm + ((wgid % nig) % gsz); u.pn = (wgid % nig) / gsz; u.item = 0;
        u.a = A + (size_t)u.pm * BM * lda * 2; u.b = Bt + (size_t)u.pn * BM * ldb * 2; return true;
    }
};

#define PG8_WAIT_V(n) asm volatile("s_waitcnt vmcnt(" #n ")" ::: "memory")
#define PG8_WAIT_L(n) asm volatile("s_waitcnt lgkmcnt(" #n ")" ::: "memory")
#define PG8_BAR __builtin_amdgcn_s_barrier()
#define PG8_SCHED __builtin_amdgcn_sched_barrier(0)

template <class Epi, class Sched>
DI void gemm_phase(LAS unsigned char* lds, const Gemm g, const Sched& S, const Epi& E, const int tid) {
    const int wid = __builtin_amdgcn_readfirstlane(tid >> 6), lane = tid & 63, wr = wid >> 2, wc = wid & 3, fr = lane & 15, fq = lane >> 4;
    int K = g.K; asm volatile("" : "+s"(K));
    const int nt = K / BK;
    unsigned voffA[2], voffB[2];
#pragma unroll
    for (int i = 0; i < 2; ++i) { int R, C; stage_rc(tid * 16 + i * 8192, R, C); const int Rb = Epi::PERM ? ((R & ~31) + perm32(R & 31)) : R;
        voffA[i] = (unsigned)(R * g.lda + C) * 2u; voffB[i] = (unsigned)(Rb * g.ldb + C) * 2u; }
    const size_t kstep = (size_t)(BK * 2);
    const size_t hstepA = (size_t)HALF * g.lda * 2, hstepB = (size_t)HALF * g.ldb * 2;
    const unsigned ldsw = (unsigned)wid * 1024u;
    const int aoff = lds_byte(wr * 64 + fr, fq * 8), boff = lds_byte(wc * 32 + fr, fq * 8);
#define PG8_SA(b, h) (((b) * 2 + (h)) * HTB)
#define PG8_SB(b, h) ((4 + (b) * 2 + (h)) * HTB)
#define PG8_STAGE(bufoff, gbase, voff) do { _Pragma("unroll") for (int _i = 0; _i < 2; ++_i) \
        __builtin_amdgcn_global_load_lds((const unsigned*)((const char*)(gbase) + (voff)[_i]), (LAS unsigned*)(lds + (bufoff) + ldsw + _i * 8192), 16, 0, 0); } while (0)
#define PG8_LDA(dst, b, h) do { _Pragma("unroll") for (int m = 0; m < 4; ++m) _Pragma("unroll") for (int k = 0; k < 2; ++k) dst[m][k] = *(const LAS bf16x8*)(lds + PG8_SA(b, h) + aoff + m * 2048 + k * 1024); } while (0)
#define PG8_LDB(dst, b, h) do { _Pragma("unroll") for (int n = 0; n < 2; ++n) _Pragma("unroll") for (int k = 0; k < 2; ++k) dst[n][k] = *(const LAS bf16x8*)(lds + PG8_SB(b, h) + boff + n * 2048 + k * 1024); } while (0)
#define PG8_MMA(ai, bj, At, Bt) do { __builtin_amdgcn_s_setprio(1); _Pragma("unroll") for (int m = 0; m < 4; ++m) _Pragma("unroll") for (int n = 0; n < 2; ++n) _Pragma("unroll") for (int k = 0; k < 2; ++k) \
        acc[ai][bj][m][n] = __builtin_amdgcn_mfma_f32_16x16x32_bf16(Bt[n][k], At[m][k], acc[ai][bj][m][n], 0, 0, 0); __builtin_amdgcn_s_setprio(0); } while (0)
    Unit cur, nxt; int ui = 0;
    if (!S.next(0, cur)) return;
    f32x4 acc[2][2][4][2];
#pragma unroll
    for (int a = 0; a < 2; ++a)
#pragma unroll
        for (int b = 0; b < 2; ++b)
#pragma unroll
            for (int m = 0; m < 4; ++m)
#pragma unroll
                for (int n = 0; n < 2; ++n) acc[a][b][m][n] = (f32x4){0.f, 0.f, 0.f, 0.f};
    bf16x8 At[4][2], B0[2][2], B1[2][2];
    const char* cA = cur.a; const char* cB = cur.b;
    PG8_STAGE(PG8_SB(0, 0), cB, voffB); PG8_STAGE(PG8_SB(0, 1), cB + hstepB, voffB); PG8_STAGE(PG8_SA(0, 0), cA, voffA); PG8_STAGE(PG8_SA(0, 1), cA + hstepA, voffA);
    if (wr == 1) PG8_BAR;
    PG8_WAIT_V(2); PG8_BAR;
    PG8_STAGE(PG8_SB(1, 0), cB + kstep, voffB); PG8_STAGE(PG8_SA(1, 0), cA + kstep, voffA); PG8_STAGE(PG8_SB(1, 1), cB + hstepB + kstep, voffB);
    PG8_WAIT_V(6); PG8_BAR;
    for (;;) {
        const bool has_next = S.next(ui + 1, nxt);
        const char* nA = has_next ? nxt.a : cA; const char* nB = has_next ? nxt.b : cB;
        for (int t = 0; t < nt; t += 2) {
            const bool last = (t == nt - 2);
            const char* a1 = cA + (size_t)(t + 1) * kstep;
            const char* a2 = last ? nA : cA + (size_t)(t + 2) * kstep; const char* b2 = last ? nB : cB + (size_t)(t + 2) * kstep;
            const char* a3 = a2 + kstep; const char* b3 = b2 + kstep;
            PG8_LDB(B0, 0, 0); PG8_LDB(B1, 0, 1); PG8_SCHED; PG8_LDA(At, 0, 0); PG8_STAGE(PG8_SA(1, 1), a1 + hstepA, voffA);
            PG8_WAIT_V(8); PG8_WAIT_L(0); PG8_BAR; PG8_MMA(0, 0, At, B0); PG8_MMA(0, 1, At, B1); PG8_BAR; PG8_SCHED;
            PG8_LDA(At, 0, 1); PG8_STAGE(PG8_SB(0, 0), b2, voffB); PG8_STAGE(PG8_SB(0, 1), b2 + hstepB, voffB); PG8_STAGE(PG8_SA(0, 0), a2, voffA);
            PG8_WAIT_V(8); PG8_WAIT_L(0); PG8_BAR; PG8_MMA(1, 0, At, B0); PG8_MMA(1, 1, At, B1); PG8_BAR; PG8_SCHED;
            PG8_LDB(B0, 1, 0); PG8_LDB(B1, 1, 1); PG8_SCHED; PG8_LDA(At, 1, 0); PG8_STAGE(PG8_SA(0, 1), a2 + hstepA, voffA);
            PG8_WAIT_V(8); PG8_WAIT_L(0); PG8_BAR; PG8_MMA(0, 0, At, B0); PG8_MMA(0, 1, At, B1); PG8_BAR; PG8_SCHED;
            PG8_LDA(At, 1, 1); PG8_STAGE(PG8_SB(1, 0), b3, voffB); PG8_STAGE(PG8_SB(1, 1), b3 + hstepB, voffB); PG8_STAGE(PG8_SA(1, 0), a3, voffA);
            PG8_WAIT_V(8); PG8_WAIT_L(0); PG8_BAR; PG8_MMA(1, 0, At, B0); PG8_MMA(1, 1, At, B1); PG8_BAR; PG8_SCHED;
        }
        if (wr == 0) PG8_BAR;
        { int fr_ = fr, fq_ = fq; asm volatile("" : "+v"(fr_), "+v"(fq_));
          E(acc, cur, wr, wc, fr_, fq_); }
        if (!has_next) break;
#pragma unroll
        for (int a = 0; a < 2; ++a)
#pragma unroll
            for (int b = 0; b < 2; ++b)
#pragma unroll
                for (int m = 0; m < 4; ++m)
#pragma unroll
                    for (int n = 0; n < 2; ++n) acc[a][b][m][n] = (f32x4){0.f, 0.f, 0.f, 0.f};
        cur = nxt; cA = nA; cB = nB; ++ui;
        if (wr == 1) PG8_BAR;
    }
    PG8_WAIT_V(0);
    PG8_BAR;
#undef PG8_SA
#undef PG8_SB
#undef PG8_STAGE
#undef PG8_LDA
#undef PG8_LDB
#undef PG8_MMA
}
}

typedef const f32x4 (&AccRef)[2][2][4][2];
DI u32x4 pack8(f32x4 v0, f32x4 v1) { u32x4 w; w.x = cvt_pk_bf16(v0[0], v0[1]); w.y = cvt_pk_bf16(v0[2], v0[3]); w.z = cvt_pk_bf16(v1[0], v1[1]); w.w = cvt_pk_bf16(v1[2], v1[3]); return w; }
DI u32x4 pack8h(f32x4 v0, f32x4 v1) { u32x4 w; w.x = pk2h(v0[0], v0[1]); w.y = pk2h(v0[2], v0[3]); w.z = pk2h(v1[0], v1[1]); w.w = pk2h(v1[2], v1[3]); return w; }

struct EpiBf16Split {
    static constexpr bool PERM = true;
    bf16_t* O0; int ld0; bf16_t* O1; int ld1; int split;
    DI void operator()(AccRef acc, const pg8::Unit& u, int wr, int wc, int fr, int fq) const {
        const int row0 = u.pm * 256 + wr * 64 + fr;
        bf16_t* base; int ld, colt;
        if (u.pn < split) { base = O0; ld = ld0; colt = u.pn * 256; } else { base = O1; ld = ld1; colt = (u.pn - split) * 256; }
        const int col0 = colt + wc * 32 + 8 * fq;
#pragma unroll
        for (int ai = 0; ai < 2; ++ai)
#pragma unroll
            for (int m = 0; m < 4; ++m) { bf16_t* rowp = base + (size_t)(row0 + ai * 128 + m * 16) * ld + col0;
#pragma unroll
                for (int bj = 0; bj < 2; ++bj) *(u32x4*)(rowp + bj * 128) = pack8(acc[ai][bj][m][0], acc[ai][bj][m][1]); }
    }
};

struct EpiResF32 {
    static constexpr bool PERM = false;
    float* out; int ldc; float alpha;
    DI void operator()(AccRef acc, const pg8::Unit& u, int wr, int wc, int fr, int fq) const {
        const int row0 = u.pm * 256 + wr * 64 + fr, col0 = u.pn * 256 + wc * 32 + 4 * fq;
#pragma unroll
        for (int ai = 0; ai < 2; ++ai)
#pragma unroll
            for (int m = 0; m < 4; ++m) { float* rowp = out + (size_t)(row0 + ai * 128 + m * 16) * ldc + col0;
#pragma unroll
                for (int bj = 0; bj < 2; ++bj)
#pragma unroll
                    for (int n = 0; n < 2; ++n) { f32x4* p = (f32x4*)(rowp + bj * 128 + n * 16); const f32x4 x = *p; *p = x * alpha + acc[ai][bj][m][n]; }
                asm volatile("" ::: "memory"); }
    }
};

struct EpiLora {
    static constexpr bool PERM = true;
    unsigned short* ewa; unsigned short* gate; const float* w0; const float* a0;
    DI void operator()(AccRef acc, const pg8::Unit& u, int wr, int wc, int fr, int fq) const {
        const int type = u.pn >> 2, cbase = (u.pn & 3) * 256 + wc * 32 + 8 * fq;
        const int row0 = u.pm * 256 + wr * 64 + fr;
        unsigned short* base = (type < 4) ? ewa + (size_t)type * T * A_W : gate;
        const float* bias = (type < 2) ? w0 + type * A_W : a0 + ((type - 2) & 1) * A_W;
#pragma unroll
        for (int bj = 0; bj < 2; ++bj) {
            const int cc = cbase + bj * 128;
            f32x4 b0 = (f32x4){0.f, 0.f, 0.f, 0.f}, b1 = b0;
            if (type < 4) { b0 = *(const f32x4*)(bias + cc); b1 = *(const f32x4*)(bias + cc + 4); }
#pragma unroll
            for (int ai = 0; ai < 2; ++ai)
#pragma unroll
                for (int m = 0; m < 4; ++m) {
                    f32x4 v0 = acc[ai][bj][m][0] + b0, v1 = acc[ai][bj][m][1] + b1;
                    u32x4 w;
                    if (type < 2) {
#pragma unroll
                        for (int e = 0; e < 4; ++e) { { const float z = -v0[e]; const float sp = fmaxf(z, 0.f) + __logf(1.0f + __expf(-fabsf(z))); v0[e] = __expf(-sp - 0.5f); }
                                                       { const float z = -v1[e]; const float sp = fmaxf(z, 0.f) + __logf(1.0f + __expf(-fabsf(z))); v1[e] = __expf(-sp - 0.5f); } }
                        w = pack8h(v0, v1);
                    } else if (type < 4) {
#pragma unroll
                        for (int e = 0; e < 4; ++e) { v0[e] = sigmoidf_(v0[e]); v1[e] = sigmoidf_(v1[e]); }
                        w = pack8h(v0, v1);
                    } else w = pack8(v0, v1);
                    *(u32x4*)(base + (size_t)(row0 + ai * 128 + m * 16) * A_W + cc) = w;
                    __builtin_amdgcn_sched_barrier(0);
                }
        }
    }
};

DI float l2gamma(int h) { return log1pf(-exp2f((float)(-5 - h))) * 1.4426950408889634f; }

struct EpiO1a {
    static constexpr bool PERM = true;
    bf16_t* QN; bf16_t* KN; bf16_t* GS; bf16_t* ACAT; const float* ropeN;
    DI void operator()(AccRef acc, const pg8::Unit& u, int wr, int wc, int fr, int fq) const {
        const int rbase = u.pm * 256 + wr * 64 + fr;
        if (u.pn >= 16) {
            const int col0 = (u.pn - 16) * 256 + wc * 32 + 8 * fq;
#pragma unroll
            for (int ai = 0; ai < 2; ++ai)
#pragma unroll
                for (int m = 0; m < 4; ++m) { bf16_t* rowp = GS + (size_t)(rbase + ai * 128 + m * 16) * C_V + col0;
#pragma unroll
                    for (int bj = 0; bj < 2; ++bj) { f32x4 v0 = acc[ai][bj][m][0], v1 = acc[ai][bj][m][1];
#pragma unroll
                        for (int e = 0; e < 4; ++e) { v0[e] = v0[e] * sigmoidf_(v0[e]); v1[e] = v1[e] * sigmoidf_(v1[e]); }
                        *(u32x4*)(rowp + bj * 128) = pack8(v0, v1); } }
            return;
        }
        const bool isq = u.pn < 8; const int h = u.pn & 7;
        const int i0 = wc * 32 + 8 * fq;
        const float l2g = l2gamma(h);
        const int seq_l = u.pm >> 4, nch = u.pm & 15; const size_t item = (size_t)((seq_l * 8 + h) * 16 + nch);
        bf16_t* nat = (isq ? QN : KN);
        const float ksc = isq ? 1.0f : 0.0625f;
#pragma unroll
        for (int ai = 0; ai < 2; ++ai)
#pragma unroll
            for (int m = 0; m < 4; ++m) {
                const int r = rbase + ai * 128 + m * 16, pos = r & (SEQ - 1), p = r & 255;
                const float* cp = ropeN + (size_t)pos * 128 + i0; const float* sp = cp + (size_t)SEQ * 128;
                const f32x4 c0 = *(const f32x4*)cp, c1 = *(const f32x4*)(cp + 4), s0 = *(const f32x4*)sp, s1 = *(const f32x4*)(sp + 4);
                const f32x4 x10 = acc[ai][0][m][0], x11 = acc[ai][0][m][1], x20 = acc[ai][1][m][0], x21 = acc[ai][1][m][1];
                const f32x4 o10 = (x10 * c0 - x20 * s0) * ksc, o11 = (x11 * c1 - x21 * s1) * ksc, o20 = (x10 * s0 + x20 * c0) * ksc, o21 = (x11 * s1 + x21 * c1) * ksc;
                bf16_t* rowp = nat + (size_t)r * C_QK + h * 256 + i0;
                *(u32x4*)(rowp) = pack8(o10, o11); *(u32x4*)(rowp + 128) = pack8(o20, o21);
                if (isq) {
                    const float gf = exp2f((float)(p + 1) * l2g), gb = exp2f((float)(256 - p) * l2g);
                    bf16_t* ap = ACAT + (item * 256 + p) * CATK + i0;
                    *(u32x4*)(ap + 256) = pack8(o10 * gf, o11 * gf); *(u32x4*)(ap + 256 + 128) = pack8(o20 * gf, o21 * gf);
                    *(u32x4*)(ap + 512) = pack8(o10 * gb, o11 * gb); *(u32x4*)(ap + 512 + 128) = pack8(o20 * gb, o21 * gb);
                }
            }
    }
};

struct EpiO1b {
    static constexpr bool PERM = true;
    bf16_t* KTF; bf16_t* KTB; bf16_t* BCAT; const float* ropeT;
    DI void operator()(AccRef acc, const pg8::Unit& u, int wr, int wc, int fr, int fq) const {
        const int tc0 = u.pn * 256 + wc * 32 + 8 * fq;
        if (u.pm >= 8) {
            const int vt = u.pm - 8, h = vt >> 1, dvb = (vt & 1) * 256 + wr * 64 + fr;
            const int seq_l = u.pn >> 4, nch = u.pn & 15; const size_t item = (size_t)((seq_l * 8 + h) * 16 + nch);
            const int p0 = wc * 32 + 8 * fq;
#pragma unroll
            for (int ai = 0; ai < 2; ++ai)
#pragma unroll
                for (int m = 0; m < 4; ++m) { bf16_t* rowp = BCAT + (item * 512 + dvb + ai * 128 + m * 16) * CATK + p0;
#pragma unroll
                    for (int bj = 0; bj < 2; ++bj) *(u32x4*)(rowp + bj * 128) = pack8(acc[ai][bj][m][0], acc[ai][bj][m][1]); }
            return;
        }
        const int h = u.pm; const float l2g = l2gamma(h);
#pragma unroll
        for (int bj = 0; bj < 2; ++bj) {
            const int tc = tc0 + bj * 128, pos = tc & (SEQ - 1), p = tc & 255;
            f32x4 gf0, gf1, gb0, gb1;
#pragma unroll
            for (int e = 0; e < 4; ++e) { gf0[e] = exp2f((float)(255 - (p + e)) * l2g) * 0.0625f; gf1[e] = exp2f((float)(255 - (p + 4 + e)) * l2g) * 0.0625f;
                                           gb0[e] = exp2f((float)(p + e) * l2g) * 0.0625f; gb1[e] = exp2f((float)(p + 4 + e) * l2g) * 0.0625f; }
#pragma unroll
            for (int m = 0; m < 4; ++m) {
                const int i = wr * 64 + m * 16 + fr;
                const float* cp = ropeT + (size_t)i * SEQ + pos; const float* sp = cp + (size_t)128 * SEQ;
                const f32x4 c0 = *(const f32x4*)cp, c1 = *(const f32x4*)(cp + 4), s0 = *(const f32x4*)sp, s1 = *(const f32x4*)(sp + 4);
                const f32x4 x10 = acc[0][bj][m][0], x11 = acc[0][bj][m][1], x20 = acc[1][bj][m][0], x21 = acc[1][bj][m][1];
                const f32x4 o10 = x10 * c0 - x20 * s0, o11 = x11 * c1 - x21 * s1, o20 = x10 * s0 + x20 * c0, o21 = x11 * s1 + x21 * c1;
                const size_t r1 = (size_t)(h * 256 + i) * OG_T + tc, r2 = r1 + (size_t)128 * OG_T;
                *(u32x4*)(KTF + r1) = pack8(o10 * gf0, o11 * gf1); *(u32x4*)(KTF + r2) = pack8(o20 * gf0, o21 * gf1);
                *(u32x4*)(KTB + r1) = pack8(o10 * gb0, o11 * gb1); *(u32x4*)(KTB + r2) = pack8(o20 * gb0, o21 * gb1);
            }
        }
    }
};

struct EpiO2 {
    static constexpr bool PERM = true;
    bf16_t* ACAT;
    DI void operator()(AccRef acc, const pg8::Unit& u, int wr, int wc, int fr, int fq) const {
        const int h = (u.item >> 4) & 7; const float l2g = l2gamma(h);
        const int s0 = wc * 32 + 8 * fq;
#pragma unroll
        for (int ai = 0; ai < 2; ++ai)
#pragma unroll
            for (int m = 0; m < 4; ++m) { const int t = ai * 128 + wr * 64 + m * 16 + fr; bf16_t* rowp = ACAT + ((size_t)u.item * 256 + t) * CATK + s0;
#pragma unroll
                for (int bj = 0; bj < 2; ++bj) { f32x4 v0 = acc[ai][bj][m][0], v1 = acc[ai][bj][m][1];
#pragma unroll
                    for (int e = 0; e < 4; ++e) { const int sa = s0 + bj * 128 + e; const int d0 = t - sa, d1 = t - sa - 4;
                        v0[e] *= exp2f((float)(d0 < 0 ? -d0 : d0) * l2g); v1[e] *= exp2f((float)(d1 < 0 ? -d1 : d1) * l2g); }
                    *(u32x4*)(rowp + bj * 128) = pack8(v0, v1); }
                __builtin_amdgcn_sched_barrier(0); }
    }
};

struct EpiKV {
    static constexpr bool PERM = false;
    float* KV;
    DI void operator()(AccRef acc, const pg8::Unit& u, int wr, int wc, int fr, int fq) const {
        float* base = KV + (size_t)u.item * 512 * 256 + (size_t)(u.pm * 256 + wr * 64 + fr) * 256 + wc * 32 + 4 * fq;
#pragma unroll
        for (int ai = 0; ai < 2; ++ai)
#pragma unroll
            for (int m = 0; m < 4; ++m)
#pragma unroll
                for (int bj = 0; bj < 2; ++bj)
#pragma unroll
                    for (int n = 0; n < 2; ++n) *(f32x4*)(base + (size_t)(ai * 128 + m * 16) * 256 + bj * 128 + n * 16) = acc[ai][bj][m][n];
    }
};

struct EpiY {
    static constexpr bool PERM = false;
    float* Y;
    DI void operator()(AccRef acc, const pg8::Unit& u, int wr, int wc, int fr, int fq) const {
        const int nch = u.item & 15, h = (u.item >> 4) & 7, seq_l = u.item >> 7;
        float* base = Y + (size_t)(seq_l * SEQ + nch * 256 + wr * 64 + fr) * C_V + h * 512 + u.pn * 256 + wc * 32 + 4 * fq;
#pragma unroll
        for (int ai = 0; ai < 2; ++ai)
#pragma unroll
            for (int m = 0; m < 4; ++m)
#pragma unroll
                for (int bj = 0; bj < 2; ++bj)
#pragma unroll
                    for (int n = 0; n < 2; ++n) *(f32x4*)(base + (size_t)(ai * 128 + m * 16) * C_V + bj * 128 + n * 16) = acc[ai][bj][m][n];
    }
};

template <int MODE> struct RetOrder {
    const char* P0; const char* P1; int G, c;
    DI bool next(int i, pg8::Unit& u) const {
        constexpr int UPI = (MODE == 0) ? 1 : 2;
        const int L = i * G + c; if (L >= OG_ITEMS * UPI) return false;
        const int item = L / UPI, sub = L % UPI; u.item = item;
        const int nch = item & 15, h = (item >> 4) & 7, seq_l = item >> 7; const size_t tok0 = (size_t)seq_l * SEQ + nch * 256;
        if (MODE == 0) { u.pm = 0; u.pn = 0; u.a = P0 + (tok0 * C_QK + h * 256) * 2; u.b = P1 + (tok0 * C_QK + h * 256) * 2; }
        else if (MODE == 1) { u.pm = sub; u.pn = 0; u.a = P0 + ((size_t)item * 512 + sub * 256) * CATK * 2; u.b = P1 + ((size_t)(h * 256) * OG_T + tok0) * 2; }
        else { u.pm = 0; u.pn = sub; u.a = P0 + (size_t)item * 256 * CATK * 2; u.b = P1 + ((size_t)item * 512 + sub * 256) * CATK * 2; }
        return true;
    }
};

#define XB_TMO      128
#define XB_XCNT(j)  (256  + 64 * (j))
#define XB_XSUB(j)  (1280 + 64 * (j))
#define XB_XGEN(j)  (2304 + 64 * (j))
#define XB_TOP      3328
#define XB_TOPGEN   3392
#define XCD_BAR_WORDS 3456
#define XB_SPIN_CAP (1u << 22)
DI unsigned xb_ld(unsigned* p)              { return __hip_atomic_load(p, __ATOMIC_RELAXED, __HIP_MEMORY_SCOPE_AGENT); }
DI unsigned xb_add(unsigned* p, unsigned v) { return __hip_atomic_fetch_add(p, v, __ATOMIC_RELAXED, __HIP_MEMORY_SCOPE_AGENT); }
DI unsigned xb_xcc_id() { return (unsigned)__builtin_amdgcn_s_getreg((3 << 11) | 20) & 0xFu; }
#define XB_SPIN(cond, bar) do { unsigned _sp = 0; while (cond) { __builtin_amdgcn_s_sleep(1); \
    if ((++_sp & 255u) == 0u) { if (xb_ld(&(bar)[XB_TMO])) break; if (_sp > XB_SPIN_CAP) { atomicAdd(&(bar)[XB_TMO], 1u); break; } } } } while (0)
struct XcdBarrier { unsigned* bar; unsigned x; volatile LAS unsigned* st; };
DI XcdBarrier xcd_barrier_post(unsigned* bar, volatile LAS unsigned* st) {
    XcdBarrier b; b.bar = bar; b.x = xb_xcc_id(); b.st = st;
    if (threadIdx.x == 0) (void)xb_add(&bar[XB_XCNT(b.x)], 1u);
    return b;
}
DI void xcd_barrier_complete(unsigned* bar, unsigned x, unsigned& nloc, unsigned& nx) {
    const unsigned G = gridDim.x * gridDim.y * gridDim.z;
    unsigned sum, cnt, mine, sp = 0u;
    for (;;) {
        sum = 0u; cnt = 0u; mine = 0u;
#pragma unroll
        for (unsigned j = 0; j < 16; ++j) { const unsigned c = xb_ld(&bar[XB_XCNT(j)]); sum += c; cnt += (c > 0u) ? 1u : 0u; mine = (j == x) ? c : mine; }
        if (sum == G) break;
        __builtin_amdgcn_s_sleep(1);
        if ((++sp & 255u) == 0u) { if (xb_ld(&bar[XB_TMO])) break; if (sp > XB_SPIN_CAP) { atomicAdd(&bar[XB_TMO], 1u); break; } }
    }
    nloc = mine > 0u ? mine : 1u; nx = cnt > 0u ? cnt : 1u;
}
DI void xcd_barrier(const XcdBarrier& b) {
    asm volatile("s_waitcnt vmcnt(0)" ::: "memory");
    __syncthreads();
    if (threadIdx.x == 0) {
        unsigned* bar = opaque_ptr(b.bar);
        __builtin_amdgcn_s_waitcnt(0);
        unsigned nloc = b.st[0], nx = b.st[1];
        if (nloc == 0u) { xcd_barrier_complete(bar, b.x, nloc, nx); b.st[0] = nloc; b.st[1] = nx; }
        const unsigned old = xb_add(&bar[XB_XSUB(b.x)], 1u);
        const unsigned gen = old / nloc;
        if (old + 1u == (gen + 1u) * nloc) {
            __builtin_amdgcn_fence(__ATOMIC_RELEASE, "agent");
            asm volatile("s_waitcnt vmcnt(0)" ::: "memory");
            const unsigned og = xb_add(&bar[XB_TOP], 1u);
            const unsigned tg = og / nx;
            if (og + 1u == (tg + 1u) * nx) xb_add(&bar[XB_TOPGEN], 1u);
            else XB_SPIN(xb_ld(&bar[XB_TOPGEN]) == tg, bar);
            __builtin_amdgcn_fence(__ATOMIC_ACQUIRE, "agent");
            xb_add(&bar[XB_XGEN(b.x)], 1u);
            asm volatile("s_waitcnt vmcnt(0)" ::: "memory");
        } else {
            XB_SPIN(xb_ld(&bar[XB_XGEN(b.x)]) == gen, bar);
            __builtin_amdgcn_fence(__ATOMIC_ACQUIRE, "agent");
            asm volatile("s_waitcnt vmcnt(0)" ::: "memory");
        }
    }
    __syncthreads();
}

struct Args { const float* in[28]; float* out; unsigned char* ws; int lo, hi; };
struct Ctx {
    LAS unsigned char* lds;
    int tid, lane, wave, G, bid;
    int gw, NGW;
    size_t gt, NGT;
};

DI void sincos_acc(float ang, float& s, float& c) {
    const double a = (double)ang; const double q = __builtin_rint(a * 0.63661977236758134308); const int n = (int)q;
    const float r = (float)(a - q * 1.57079632679489661923);
    const float r2 = r * r;
    const float sp = r + r * r2 * (-1.6666654611e-1f + r2 * (8.3321608736e-3f + r2 * -1.9515295891e-4f));
    const float cp = 1.0f - 0.5f * r2 + r2 * r2 * (4.166664568298827e-2f + r2 * (-1.388731625493765e-3f + r2 * 2.443315711809948e-5f));
    switch (n & 3) { case 0: s = sp; c = cp; break; case 1: s = cp; c = -sp; break; case 2: s = -sp; c = -cp; break; default: s = -cp; c = sp; break; }
}
DI void phase_init(const Ctx& C, const Args& A) {
    const f32x4* xp = (const f32x4*)A.in[0]; const f32x4* xs = (const f32x4*)A.in[1];
    f32x4* o = (f32x4*)A.out; u32x2* xb = (u32x2*)(A.ws + WS_XB);
    const size_t n4 = (size_t)T * D / 4, np4 = (size_t)8 * SEQ * D / 4;
    for (size_t i = C.gt; i < n4; i += C.NGT) { const f32x4 v = (i < np4) ? xp[i] : xs[i - np4]; o[i] = v; u32x2 w; w.x = pk2(v[0], v[1]); w.y = pk2(v[2], v[3]); xb[i] = w; }
    float* rn = (float*)(A.ws + WS_ROPE_N); float* rt = (float*)(A.ws + WS_ROPE_T);
    for (size_t i = C.gt; i < (size_t)SEQ * 128; i += C.NGT) {
        const int pos = (int)(i >> 7), k = (int)(i & 127);
        const float inv = (float)exp2(-(double)k * (13.287712379549449 / 128.0));
        const float ang = (float)pos * inv; float s, c; sincos_acc(ang, s, c);
        rn[i] = c; rn[(size_t)SEQ * 128 + i] = s;
        rt[(size_t)k * SEQ + pos] = c; rt[(size_t)128 * SEQ + (size_t)k * SEQ + pos] = s;
    }
}

DI void xpose_item(const float* W, int ldw, int c0, int K, bf16_t* WT, int drow0, LAS float* scr, int item, int nblk, int lane, int remap) {
    const int kb = item / nblk, nb = item % nblk, k0 = 64 * kb, n0 = 32 * nb;
#pragma unroll 8
    for (int i = 0; i < 32; ++i) { const int kk = 2 * i + (lane >> 5); scr[kk * 33 + (lane & 31)] = W[(size_t)(k0 + kk) * ldw + c0 + n0 + (lane & 31)]; }
    asm volatile("s_waitcnt lgkmcnt(0)" ::: "memory");
    const int c = lane & 7;
#pragma unroll
    for (int j = 0; j < 4; ++j) { const int n = (lane >> 3) + 8 * j; const LAS float* s = scr + (8 * c) * 33 + n;
        u32x4 o; o.x = pk2(s[0 * 33], s[1 * 33]); o.y = pk2(s[2 * 33], s[3 * 33]); o.z = pk2(s[4 * 33], s[5 * 33]); o.w = pk2(s[6 * 33], s[7 * 33]);
        const int nn = n0 + n, drow = remap ? 256 * (nn >> 7) + (nn & 127) + drow0 : drow0 + nn;
        *(u32x4*)(WT + (size_t)drow * K + k0 + 8 * c) = o; }
    asm volatile("s_waitcnt lgkmcnt(0)" ::: "memory");
}
struct XJob { const float* W; int ldw, c0, ncols, K; bf16_t* WT; int drow0; int remap; };
DI bool xpose_run(const Ctx& C, const XJob& j, int& base) {
    const int nblk = j.ncols / 32, items = (j.K / 64) * nblk;
    LAS float* scr = (LAS float*)(C.lds + C.wave * 16384);
    int it = (C.gw - (base % C.NGW) + C.NGW) % C.NGW;
    for (; it < items; it += C.NGW) xpose_item(j.W, j.ldw, j.c0, j.K, j.WT, j.drow0, scr, it, nblk, C.lane, j.remap);
    base += items; return true;
}
DI void phase_wprep(const Ctx& C, const Args& A, int l) {
    const int e = l >> 1; int base = 0;
    if (!(l & 1)) {
        XJob j0{A.in[2] + (size_t)e * D * AB_IN, AB_IN, 0, AB_IN, D, (bf16_t*)(A.ws + WE_IN), 0, 0}; xpose_run(C, j0, base);
        XJob j1{A.in[15] + (size_t)e * D * D, D, 0, D, D, (bf16_t*)(A.ws + WE_OUT), 0, 0}; xpose_run(C, j1, base);
        XJob j2{A.in[22] + (size_t)l * D * FF2, FF2, 0, D_FF, D, (bf16_t*)(A.ws + WE_UP), 0, 1}; xpose_run(C, j2, base);
        XJob j2u{A.in[22] + (size_t)l * D * FF2, FF2, D_FF, D_FF, D, (bf16_t*)(A.ws + WE_UP), 128, 1}; xpose_run(C, j2u, base);
        XJob j3{A.in[25] + (size_t)l * D_FF * D, D, 0, D, D_FF, (bf16_t*)(A.ws + WE_DN), 0, 0}; xpose_run(C, j3, base);
        const float* wup = A.in[5] + (size_t)e * 2 * 64 * A_W; const float* aup = A.in[7] + (size_t)e * 2 * 64 * A_W; const float* gup = A.in[8] + (size_t)e * 128 * A_W;
        bf16_t* lt = (bf16_t*)(A.ws + WE_LORA);
        for (size_t i = C.gt; i < (size_t)LORA_N * LORA_K; i += C.NGT) {
            const int row = (int)(i >> 8), kk = (int)(i & 255), type = row >> 10, c = row & 1023; float v = 0.f;
            if (type < 2) { if (kk < 64) v = wup[((size_t)type * 64 + kk) * A_W + c]; }
            else if (type < 4) { if (kk >= 64 && kk < 128) v = aup[((size_t)(type - 2) * 64 + (kk - 64)) * A_W + c]; }
            else { if (kk >= 128) v = gup[(size_t)(kk - 128) * A_W + c]; }
            lt[i] = (bf16_t)f2bf(v);
        }
    } else {
        const float* cin = A.in[16] + (size_t)e * D * C_IN; bf16_t* ct = (bf16_t*)(A.ws + WO_IN);
        XJob q{cin, C_IN, 0, 2048, D, ct, 0, 0}; xpose_run(C, q, base);
        XJob k{cin, C_IN, 2048, 2048, D, ct, 2048, 0}; xpose_run(C, k, base);
        XJob g{cin, C_IN, 8192, 4096, D, ct, 4096, 0}; xpose_run(C, g, base);
        XJob k2{cin, C_IN, 2048, 2048, D, ct, 8192, 0}; xpose_run(C, k2, base);
        XJob v{cin, C_IN, 4096, 4096, D, ct, 10240, 0}; xpose_run(C, v, base);
        XJob o{A.in[19] + (size_t)e * C_V * D, D, 0, D, C_V, (bf16_t*)(A.ws + WO_OUT), 0, 0}; xpose_run(C, o, base);
        XJob j2{A.in[22] + (size_t)l * D * FF2, FF2, 0, D_FF, D, (bf16_t*)(A.ws + WO_UP), 0, 1}; xpose_run(C, j2, base);
        XJob j2u{A.in[22] + (size_t)l * D * FF2, FF2, D_FF, D_FF, D, (bf16_t*)(A.ws + WO_UP), 128, 1}; xpose_run(C, j2u, base);
        XJob j3{A.in[25] + (size_t)l * D_FF * D, D, 0, D, D_FF, (bf16_t*)(A.ws + WO_DN), 0, 0}; xpose_run(C, j3, base);
    }
}

DI void phase_ln(const Ctx& C, const Args& A, int row0, int nrows, const float* g, const float* b) {
    for (int m = row0 + C.gw; m < row0 + nrows; m += C.NGW) {
        f32x4* xr = (f32x4*)(A.out + (size_t)m * D) + C.lane;
        f32x4 v[8]; float s = 0.f;
#pragma unroll
        for (int j = 0; j < 8; ++j) { v[j] = xr[64 * j]; s += (v[j][0] + v[j][1]) + (v[j][2] + v[j][3]); }
        const float mean = wave_sum(s) * (1.f / D); float s2 = 0.f;
#pragma unroll
        for (int j = 0; j < 8; ++j) { v[j] = v[j] - mean; s2 += (v[j][0] * v[j][0] + v[j][1] * v[j][1]) + (v[j][2] * v[j][2] + v[j][3] * v[j][3]); }
        const float rstd = 1.f / sqrtf(wave_sum(s2) * (1.f / D) + LN_EPS);
        u32x2* o8 = (u32x2*)((bf16_t*)(A.ws + WS_XB) + (size_t)m * D) + C.lane;
#pragma unroll
        for (int j = 0; j < 8; ++j) { const f32x4 gg = ((const f32x4*)g)[C.lane + 64 * j], bb = ((const f32x4*)b)[C.lane + 64 * j];
            const f32x4 y = v[j] * rstd * gg + bb; xr[64 * j] = y; u32x2 w; w.x = pk2(y[0], y[1]); w.y = pk2(y[2], y[3]); o8[64 * j] = w; }
    }
}

DI void phase_na(const Ctx& C, const Args& A, int e) {
    const bf16_t* QK = (const bf16_t*)(A.ws + WS_HB); const bf16_t* VT = (const bf16_t*)(A.ws + WS_VT); bf16_t* YAB = (bf16_t*)(A.ws + WS_YAB);
    LAS float* rp = (LAS float*)C.lds;
    { const float* rpb = A.in[14] + (size_t)e * 16 * 465; for (int i = C.tid; i < 16 * 465; i += NWAVES * 64) rp[i] = rpb[i]; }
    __syncthreads();
    const int lane = C.lane, ql = lane & 15, quad = lane >> 4;
    for (int task = C.gw; task < NSEQ * 16 * 64 * 4; task += C.NGW) {
        const int nb = task & 3, r = (task >> 2) & 63, h = (task >> 8) & 15, sq = task >> 12;
        const int rs = min(max(r - 4, 0), 56), span0 = min(max(nb * 16 - 8, 0), 32);
        const int qc = nb * 16 + ql, cs = min(max(qc - 8, 0), 48);
        const size_t tq = (size_t)sq * SEQ + r * 64 + qc;
        bf16x8 qf[2];
#pragma unroll
        for (int ks = 0; ks < 2; ++ks) qf[ks] = *(const bf16x8*)(QK + tq * 2048 + h * 64 + ks * 32 + quad * 8);
        f32x4 sc[16];
#pragma unroll
        for (int g4 = 0; g4 < 4; ++g4) {
            bf16x8 kf[4][2];
#pragma unroll
            for (int u = 0; u < 4; ++u) { const int tt = g4 * 4 + u, i = tt >> 1, half = tt & 1; const size_t tk = (size_t)sq * SEQ + (rs + i) * 64 + span0 + half * 16 + ql;
#pragma unroll
                for (int ks = 0; ks < 2; ++ks) kf[u][ks] = *(const bf16x8*)(QK + tk * 2048 + 1024 + h * 64 + ks * 32 + quad * 8); }
#pragma unroll
            for (int u = 0; u < 4; ++u) { f32x4 a = (f32x4){0.f, 0.f, 0.f, 0.f};
                a = __builtin_amdgcn_mfma_f32_16x16x32_bf16(kf[u][0], qf[0], a, 0, 0, 0); a = __builtin_amdgcn_mfma_f32_16x16x32_bf16(kf[u][1], qf[1], a, 0, 0, 0); sc[g4 * 4 + u] = a; }
        }
        float mx = -1e30f;
#pragma unroll
        for (int tt = 0; tt < 16; ++tt) { const int i = tt >> 1, half = tt & 1; const LAS float* brow = rp + (h * 15 + (rs + i - r + 7)) * 31;
#pragma unroll
            for (int g = 0; g < 4; ++g) { const int kc = span0 + half * 16 + quad * 4 + g; const bool valid = (kc >= cs) && (kc < cs + 16);
                const int bi = min(max(kc - qc + 15, 0), 30);
                const float s = valid ? sc[tt][g] * 0.125f + brow[bi] : -1e30f; sc[tt][g] = s; mx = fmaxf(mx, s); } }
        mx = fmaxf(mx, __shfl_xor(mx, 16)); mx = fmaxf(mx, __shfl_xor(mx, 32));
        float l = 0.f;
#pragma unroll
        for (int tt = 0; tt < 16; ++tt)
#pragma unroll
            for (int g = 0; g < 4; ++g) { const float p = __expf(sc[tt][g] - mx); sc[tt][g] = p; l += p; }
        l += __shfl_xor(l, 16); l += __shfl_xor(l, 32);
        f32x4 o[4];
#pragma unroll
        for (int dt = 0; dt < 4; ++dt) o[dt] = (f32x4){0.f, 0.f, 0.f, 0.f};
#pragma unroll
        for (int i = 0; i < 8; ++i) {
            u32x4 pw; pw.x = cvt_pk_bf16(sc[2 * i][0], sc[2 * i][1]); pw.y = cvt_pk_bf16(sc[2 * i][2], sc[2 * i][3]); pw.z = cvt_pk_bf16(sc[2 * i + 1][0], sc[2 * i + 1][1]); pw.w = cvt_pk_bf16(sc[2 * i + 1][2], sc[2 * i + 1][3]);
            const bf16x8 pf = __builtin_bit_cast(bf16x8, pw);
            const size_t tk = (size_t)sq * SEQ + (rs + i) * 64 + span0 + quad * 4;
#pragma unroll
            for (int dt = 0; dt < 4; ++dt) { const bf16_t* vp = VT + (size_t)(h * 64 + dt * 16 + ql) * T + tk;
                u32x4 vw; const u32x2 v0 = *(const u32x2*)vp, v1 = *(const u32x2*)(vp + 16); vw.x = v0.x; vw.y = v0.y; vw.z = v1.x; vw.w = v1.y;
                o[dt] = __builtin_amdgcn_mfma_f32_16x16x32_bf16(__builtin_bit_cast(bf16x8, vw), pf, o[dt], 0, 0, 0); }
        }
        const float il = 1.0f / l;
        bf16_t* op = YAB + tq * D + 1024 + h * 64 + quad * 4;
#pragma unroll
        for (int dt = 0; dt < 4; ++dt) { u32x2 w; w.x = pk2(o[dt][0] * il, o[dt][1] * il); w.y = pk2(o[dt][2] * il, o[dt][3] * il); *(u32x2*)(op + dt * 16) = w; }
    }
}

DI void unpack8(const u32x4 w, float (&f)[8]) { f[0] = bflo(w.x); f[1] = bfhi(w.x); f[2] = bflo(w.y); f[3] = bfhi(w.y); f[4] = bflo(w.z); f[5] = bfhi(w.z); f[6] = bflo(w.w); f[7] = bfhi(w.w); }
DI void phase_conv_a(const Ctx& C, const Args& A, int e) {
    const bf16_t* HA = (const bf16_t*)(A.ws + WS_HA); bf16_t* RK = (bf16_t*)(A.ws + WS_HB); bf16_t* LIN = (bf16_t*)(A.ws + WS_LIN);
    const float* sh = A.in[3] + (size_t)e * 3 * A_COLS; const float* k_k = A.in[9] + (size_t)e * A_W; float* KKN = (float*)(A.ws + WS_KKN);
    constexpr int C8 = A_COLS / 8;
    for (size_t i = C.gt; i < (size_t)T * C8; i += C.NGT) {
        const int t = (int)(i / C8), c8 = (int)(i % C8), c = c8 * 8, pos = t & (SEQ - 1);
        float x0[8], x1[8], x2[8];
        const u32x4 z = (u32x4){0u, 0u, 0u, 0u};
        unpack8(pos > 0 ? *(const u32x4*)(HA + (size_t)(t - 1) * A_COLS + c) : z, x0);
        unpack8(*(const u32x4*)(HA + (size_t)t * A_COLS + c), x1);
        unpack8(pos < SEQ - 1 ? *(const u32x4*)(HA + (size_t)(t + 1) * A_COLS + c) : z, x2);
        float y[8];
#pragma unroll
        for (int j = 0; j < 8; ++j) y[j] = sh[c + j] * x0[j] + sh[A_COLS + c + j] * x1[j] + sh[2 * A_COLS + c + j] * x2[j];
        {
            float p = 0.f;
            if (c >= 1024 && c < 2048) {
#pragma unroll
                for (int j = 0; j < 8; ++j) { const float kb = bf2f((unsigned short)f2bf(y[j])) * k_k[c - 1024 + j]; p += kb * kb; } }
            p += __shfl_xor(p, 1); p += __shfl_xor(p, 2); p += __shfl_xor(p, 4);
            if (c >= 1024 && c < 2048 && (c8 & 7) == 0) KKN[(size_t)t * 16 + ((c - 1024) >> 6)] = 1.0f / fmaxf(sqrtf(p), 1e-12f);
        }
        if (c < 3072) { u32x4 w; w.x = pk2(y[0], y[1]); w.y = pk2(y[2], y[3]); w.z = pk2(y[4], y[5]); w.w = pk2(y[6], y[7]); *(u32x4*)(RK + (size_t)t * NB_COLS + c) = w; }
        else { const int cc = c - 3072;
#pragma unroll
            for (int j = 0; j < 8; ++j) { if (cc < 64) y[j] = tanhf(y[j]); else if (cc >= 128) y[j] = sigmoidf_(y[j]); }
            u32x4 w; w.x = pk2(y[0], y[1]); w.y = pk2(y[2], y[3]); w.z = pk2(y[4], y[5]); w.w = pk2(y[6], y[7]); *(u32x4*)(LIN + (size_t)t * LORA_K + cc) = w; }
    }
}

#define DPP_FMAC(acc, bvec, x, N) asm("v_fmac_f32_dpp %0, %1, %2 row_newbcast:" #N " row_mask:0xf bank_mask:0xf" : "+v"(acc) : "v"(bvec), "v"(x))
#define DPP_MUL(dst, bvec, x, N)  asm("v_mul_f32_dpp %0, %1, %2 row_newbcast:" #N " row_mask:0xf bank_mask:0xf" : "=v"(dst) : "v"(bvec), "v"(x))
DI float xrow_sum(float x) {
    float a = x, b = x;
    asm("s_nop 1\n\tv_permlane16_swap_b32 %0, %1" : "+v"(a), "+v"(b));
    const float s = a + b; float c = s, d = s;
    asm("s_nop 1\n\tv_permlane32_swap_b32 %0, %1" : "+v"(c), "+v"(d));
    return c + d;
}
template <int DIR> DI void scan_task(const Ctx& C, const Args& A, int e, int sq, int h, int wv) {
    constexpr int PD = 8;
    const int lane = C.lane, il = lane & 15;
    const size_t tb = (size_t)sq * SEQ;
    const bf16_t* rkp = (const bf16_t*)(A.ws + WS_HB) + tb * NB_COLS + h * 64;
    const unsigned short* ewp = (const unsigned short*)(A.ws + WS_EWA) + (size_t)DIR * T * A_W + tb * A_W + h * 64 + lane;
    const unsigned short* aap = (const unsigned short*)(A.ws + WS_EWA) + (size_t)(2 + DIR) * T * A_W + tb * A_W + h * 64 + lane;
    const float* knp = (const float*)(A.ws + WS_KKN) + tb * 16 + h;
    bf16_t* yo = (bf16_t*)(A.ws + (DIR ? WS_YBK : WS_YF)) + tb * A_W + h * 64 + 16 * wv + il;
    const float kk_c = (A.in[9] + (size_t)e * A_W)[h * 64 + lane], ka_c = (A.in[10] + (size_t)e * A_W)[h * 64 + lane];
    float S[16];
#pragma unroll
    for (int n = 0; n < 16; ++n) S[n] = 0.f;
    unsigned short pr[PD], pk[PD], pv[PD], pw[PD], pa[PD]; float pn[PD];
#define SCAN_T(st) ((size_t)(DIR ? (SEQ - 1 - (st)) : (st)))
#define SCAN_LOAD(slot, st) do { const size_t t_ = SCAN_T(st); pr[slot] = rkp[t_ * NB_COLS + lane]; pk[slot] = rkp[t_ * NB_COLS + 1024 + lane]; pv[slot] = rkp[t_ * NB_COLS + 2048 + 16 * wv + il]; \
        pw[slot] = ewp[t_ * A_W]; pa[slot] = aap[t_ * A_W]; pn[slot] = knp[t_ * 16]; } while (0)
#define SCAN_OPS(slot) do { const float k_ = bf2f(pk[slot]), a_ = h2f(pa[slot]); kk = k_ * kk_c * pn[slot]; w = __expf(-h2f(pw[slot])); ka = kk * a_; kd = k_ * (1.0f + (a_ - 1.0f) * ka_c); rr = bf2f(pr[slot]); vv = bf2f(pv[slot]); } while (0)
#pragma unroll
    for (int s = 0; s < PD; ++s) SCAN_LOAD(s, s);
    float kk, w, ka, kd, rr, vv;
    SCAN_OPS(0);
    for (int b = 0; b < SEQ / PD; ++b) {
#pragma unroll
        for (int s = 0; s < PD; ++s) {
            const int st = b * PD + s;
            asm volatile("s_nop 1" : "+v"(kk), "+v"(w), "+v"(ka), "+v"(kd), "+v"(rr));
            float sa0, sa1, sa2, sa3, y0, y1, y2, y3;
            DPP_MUL(sa0, kk, S[0], 0); DPP_MUL(sa1, kk, S[1], 1); DPP_MUL(sa2, kk, S[2], 2); DPP_MUL(sa3, kk, S[3], 3);
            DPP_FMAC(sa0, kk, S[4], 4); DPP_FMAC(sa1, kk, S[5], 5); DPP_FMAC(sa2, kk, S[6], 6); DPP_FMAC(sa3, kk, S[7], 7);
            DPP_FMAC(sa0, kk, S[8], 8); DPP_FMAC(sa1, kk, S[9], 9); DPP_FMAC(sa2, kk, S[10], 10); DPP_FMAC(sa3, kk, S[11], 11);
            DPP_FMAC(sa0, kk, S[12], 12); DPP_FMAC(sa1, kk, S[13], 13); DPP_FMAC(sa2, kk, S[14], 14); DPP_FMAC(sa3, kk, S[15], 15);
            if (DIR == 1) {
                DPP_MUL(y0, rr, S[0], 0); DPP_MUL(y1, rr, S[1], 1); DPP_MUL(y2, rr, S[2], 2); DPP_MUL(y3, rr, S[3], 3);
                DPP_FMAC(y0, rr, S[4], 4); DPP_FMAC(y1, rr, S[5], 5); DPP_FMAC(y2, rr, S[6], 6); DPP_FMAC(y3, rr, S[7], 7);
                DPP_FMAC(y0, rr, S[8], 8); DPP_FMAC(y1, rr, S[9], 9); DPP_FMAC(y2, rr, S[10], 10); DPP_FMAC(y3, rr, S[11], 11);
                DPP_FMAC(y0, rr, S[12], 12); DPP_FMAC(y1, rr, S[13], 13); DPP_FMAC(y2, rr, S[14], 14); DPP_FMAC(y3, rr, S[15], 15);
            }
            const float sa = -xrow_sum((sa0 + sa1) + (sa2 + sa3));
#define SCAN_UPD(n) { float t_; DPP_MUL(t_, kd, vv, n); DPP_FMAC(t_, ka, sa, n); DPP_FMAC(t_, w, S[n], n); S[n] = t_; }
            SCAN_UPD(0) SCAN_UPD(1) SCAN_UPD(2) SCAN_UPD(3) SCAN_UPD(4) SCAN_UPD(5) SCAN_UPD(6) SCAN_UPD(7)
            SCAN_UPD(8) SCAN_UPD(9) SCAN_UPD(10) SCAN_UPD(11) SCAN_UPD(12) SCAN_UPD(13) SCAN_UPD(14) SCAN_UPD(15)
#undef SCAN_UPD
            if (DIR == 0) {
                DPP_MUL(y0, rr, S[0], 0); DPP_MUL(y1, rr, S[1], 1); DPP_MUL(y2, rr, S[2], 2); DPP_MUL(y3, rr, S[3], 3);
                DPP_FMAC(y0, rr, S[4], 4); DPP_FMAC(y1, rr, S[5], 5); DPP_FMAC(y2, rr, S[6], 6); DPP_FMAC(y3, rr, S[7], 7);
                DPP_FMAC(y0, rr, S[8], 8); DPP_FMAC(y1, rr, S[9], 9); DPP_FMAC(y2, rr, S[10], 10); DPP_FMAC(y3, rr, S[11], 11);
                DPP_FMAC(y0, rr, S[12], 12); DPP_FMAC(y1, rr, S[13], 13); DPP_FMAC(y2, rr, S[14], 14); DPP_FMAC(y3, rr, S[15], 15);
            }
            const float y = xrow_sum((y0 + y1) + (y2 + y3));
            if (lane < 16) yo[SCAN_T(st) * A_W] = (bf16_t)f2bf(y);
            { const int sn = st + PD < SEQ ? st + PD : SEQ - 1; SCAN_LOAD(s, sn); }
            SCAN_OPS((s + 1) % PD);
        }
    }
#undef SCAN_T
#undef SCAN_LOAD
#undef SCAN_OPS
}
DI void phase_scan(const Ctx& C, const Args& A, int e) {
    for (int hp = C.bid; hp < NSEQ * 16; hp += C.G) {
        const int sq = hp >> 4, h = hp & 15, wv = C.wave & 3;
        if (C.wave < 4) scan_task<0>(C, A, e, sq, h, wv); else scan_task<1>(C, A, e, sq, h, wv);
    }
}

DI void phase_rwkv_post(const Ctx& C, const Args& A, int e) {
    const bf16_t* RK = (const bf16_t*)(A.ws + WS_HB); const unsigned short* AF = (const unsigned short*)(A.ws + WS_EWA) + (size_t)2 * T * A_W;
    const bf16_t* YF = (const bf16_t*)(A.ws + WS_YF); const bf16_t* YB = (const bf16_t*)(A.ws + WS_YBK); const bf16_t* GT = (const bf16_t*)(A.ws + WS_GATE);
    bf16_t* YAB = (bf16_t*)(A.ws + WS_YAB);
    const float* k_a = A.in[10] + (size_t)e * A_W; const float* r_k = A.in[11] + (size_t)e * A_W; const float* gg = A.in[12] + (size_t)e * A_W; const float* gb = A.in[13] + (size_t)e * A_W;
    for (int task = C.gw; task < T * 16; task += C.NGW) {
        const int t = task >> 4, h = task & 15, c = h * 64 + C.lane;
        const float y = bf2f(YF[(size_t)t * A_W + c]) + bf2f(YB[(size_t)t * A_W + c]);
        const float mu = wave_sum(y) * (1.f / 64.f); const float d = y - mu; const float var = wave_sum(d * d) * (1.f / 64.f);
        const float yn = d * (1.0f / sqrtf(var + A_GN_EPS)) * gg[c] + gb[c];
        const float r = bf2f(RK[(size_t)t * NB_COLS + c]), k = bf2f(RK[(size_t)t * NB_COLS + 1024 + c]), v = bf2f(RK[(size_t)t * NB_COLS + 2048 + c]);
        const float a = h2f(AF[(size_t)t * A_W + c]);
        const float kf = k * (1.0f + (a - 1.0f) * k_a[c]);
        const float bs = wave_sum(r * kf * r_k[c]);
        const float o = (yn + bs * v) * bf2f(GT[(size_t)t * A_W + c]);
        YAB[(size_t)t * D + c] = (bf16_t)f2bf(o);
    }
}

DI f32x2 gelu_pk(f32x2 v) {
    const f32x2 av = __builtin_elementwise_abs(v), d = av * 0.2316418882f + 1.0f;
    f32x2 t; t.x = __builtin_amdgcn_rcpf(d.x); t.y = __builtin_amdgcn_rcpf(d.y);
    f32x2 q = t * 0.5307027145f + (-0.7265760135f); q = q * t + 0.7107068705f; q = q * t + (-0.142248368f); q = q * t + 0.127414796f; q = q * t;
    const f32x2 s = (v * v) * (-0.72134752044f);
    f32x2 e; e.x = __builtin_amdgcn_exp2f(s.x); e.y = __builtin_amdgcn_exp2f(s.y);
    const f32x2 m = v * (q * e), r = v - m;
    f32x2 o; o.x = v.x < 0.f ? m.x : r.x; o.y = v.y < 0.f ? m.y : r.y; return o;
}
DI float gelu1(float v) { const f32x2 r = gelu_pk((f32x2){v, v}); return r.x; }
template <int CTRL> DI float dpp1(float v) { return __builtin_bit_cast(float, __builtin_amdgcn_update_dpp(0, __builtin_bit_cast(int, v), CTRL, 0xf, 0xf, false)); }
template <int CTRL> DI f32x4 dpp4(f32x4 v) { f32x4 r; r.x = dpp1<CTRL>(v.x); r.y = dpp1<CTRL>(v.y); r.z = dpp1<CTRL>(v.z); r.w = dpp1<CTRL>(v.w); return r; }
struct EpiFfnAct {
    static constexpr bool PERM = true;
    bf16_t* ACT; float* EDGE; const float* cw; const float* cb; LAS float* eb;
    DI void operator()(AccRef acc, const pg8::Unit& u, int wr, int wc, int fr, int fq) const {
        const int j0 = wc * 32 + 8 * fq, cg = u.pn * 128 + j0;
#pragma unroll
        for (int ai = 0; ai < 2; ++ai) { const int slab = 2 * ai + wr + 1;
            if (fr == 0) { *(LAS f32x4*)(eb + (slab * 2 + 0) * 128 + j0) = acc[ai][0][0][0]; *(LAS f32x4*)(eb + (slab * 2 + 0) * 128 + j0 + 4) = acc[ai][0][0][1]; }
            if (fr == 15) { *(LAS f32x4*)(eb + (slab * 2 + 1) * 128 + j0) = acc[ai][0][3][0]; *(LAS f32x4*)(eb + (slab * 2 + 1) * 128 + j0 + 4) = acc[ai][0][3][1]; } }
        { float* ed = EDGE + ((size_t)(u.pm * FF_NT + u.pn) * 6) * 128 + j0;
          if (wr == 0 && fr < 2) { *(f32x4*)(ed + fr * 128) = acc[0][0][0][0]; *(f32x4*)(ed + fr * 128 + 4) = acc[0][0][0][1]; if (fr == 0) { *(f32x4*)(ed + 4 * 128) = acc[0][1][0][0]; *(f32x4*)(ed + 4 * 128 + 4) = acc[0][1][0][1]; } }
          if (wr == 1 && fr >= 14) { *(f32x4*)(ed + (fr - 12) * 128) = acc[1][0][3][0]; *(f32x4*)(ed + (fr - 12) * 128 + 4) = acc[1][0][3][1]; if (fr == 15) { *(f32x4*)(ed + 5 * 128) = acc[1][1][3][0]; *(f32x4*)(ed + 5 * 128 + 4) = acc[1][1][3][1]; } } }
        const f32x4 w00 = *(const f32x4*)(cw + cg), w01 = *(const f32x4*)(cw + cg + 4), w10 = *(const f32x4*)(cw + D_FF + cg), w11 = *(const f32x4*)(cw + D_FF + cg + 4);
        const f32x4 w20 = *(const f32x4*)(cw + 2 * D_FF + cg), w21 = *(const f32x4*)(cw + 2 * D_FF + cg + 4), b0 = *(const f32x4*)(cb + cg), b1 = *(const f32x4*)(cb + cg + 4);
        asm volatile("s_waitcnt lgkmcnt(0)" ::: "memory"); __builtin_amdgcn_s_barrier(); asm volatile("" ::: "memory");
#pragma unroll
        for (int ai = 0; ai < 2; ++ai) { const int slab = 2 * ai + wr + 1;
            const f32x4 pl0 = *(const LAS f32x4*)(eb + ((slab - 1) * 2 + 1) * 128 + j0), pl1 = *(const LAS f32x4*)(eb + ((slab - 1) * 2 + 1) * 128 + j0 + 4);
            const f32x4 nl0 = *(const LAS f32x4*)(eb + ((slab + 1) * 2 + 0) * 128 + j0), nl1 = *(const LAS f32x4*)(eb + ((slab + 1) * 2 + 0) * 128 + j0 + 4);
#pragma unroll
            for (int m = 0; m < 4; ++m) {
                const f32x4 g0 = acc[ai][0][m][0], g1 = acc[ai][0][m][1];
                f32x4 p0 = dpp4<0x121>(g0), p1 = dpp4<0x121>(g1), n0 = dpp4<0x12F>(g0), n1 = dpp4<0x12F>(g1);
                if (m > 0) { const f32x4 q0 = dpp4<0x121>(acc[ai][0][m > 0 ? m - 1 : 0][0]), q1 = dpp4<0x121>(acc[ai][0][m > 0 ? m - 1 : 0][1]); if (fr == 0) { p0 = q0; p1 = q1; } }
                else if (fr == 0) { p0 = pl0; p1 = pl1; }
                if (m < 3) { const f32x4 q0 = dpp4<0x12F>(acc[ai][0][m < 3 ? m + 1 : 3][0]), q1 = dpp4<0x12F>(acc[ai][0][m < 3 ? m + 1 : 3][1]); if (fr == 15) { n0 = q0; n1 = q1; } }
                else if (fr == 15) { n0 = nl0; n1 = nl1; }
                f32x4 x0 = w00 * p0 + w10 * g0 + w20 * n0 + b0, x1 = w01 * p1 + w11 * g1 + w21 * n1 + b1;
                const f32x2 a = gelu_pk((f32x2){x0[0], x0[1]}), b = gelu_pk((f32x2){x0[2], x0[3]}), c = gelu_pk((f32x2){x1[0], x1[1]}), d = gelu_pk((f32x2){x1[2], x1[3]});
                x0 = (f32x4){a.x, a.y, b.x, b.y} * acc[ai][1][m][0]; x1 = (f32x4){c.x, c.y, d.x, d.y} * acc[ai][1][m][1];
                *(u32x4*)(ACT + (size_t)(u.pm * 256 + ai * 128 + wr * 64 + m * 16 + fr) * D_FF + cg) = pack8(x0, x1);
                __builtin_amdgcn_sched_barrier(0);
            } }
    }
};
DI void phase_ffn_fix(const Ctx& C, const Args& A, int l) {
    const float* ED = (const float*)(A.ws + WS_EDGE); bf16_t* ACT = (bf16_t*)(A.ws + WS_ACT);
    const float* cw = A.in[23] + (size_t)l * 3 * D_FF; const float* cb = A.in[24] + (size_t)l * D_FF;
    const size_t n = (size_t)(T / 256) * FF_NT * 2 * 128;
    for (size_t i = C.gt; i < n; i += C.NGT) {
        const int j = (int)(i & 127), which = (int)((i >> 7) & 1); const int tile = (int)(i >> 8), pn = tile % FF_NT, pm = tile / FF_NT, c = pn * 128 + j;
        const float* e = ED + (size_t)tile * 6 * 128 + j;
        float pv, cv, nv, up;
        if (which == 0) { pv = (pm & 15) ? ED[((size_t)(tile - FF_NT) * 6 + 3) * 128 + j] : 0.f; cv = e[0]; nv = e[128]; up = e[4 * 128]; }
        else { pv = e[2 * 128]; cv = e[3 * 128]; nv = ((pm & 15) != 15) ? ED[((size_t)(tile + FF_NT) * 6 + 0) * 128 + j] : 0.f; up = e[5 * 128]; }
        const float g = cw[c] * pv + cw[D_FF + c] * cv + cw[2 * D_FF + c] * nv + cb[c];
        ACT[(size_t)(pm * 256 + (which ? 255 : 0)) * D_FF + c] = (bf16_t)f2bf(gelu1(g) * up);
    }
}

DI void phase_ret_scan(const Ctx& C, const Args& A) {
    const float* KVF = (const float*)(A.ws + WS_KVF); const float* KVB = (const float*)(A.ws + WS_KVB); bf16_t* BC = (bf16_t*)(A.ws + WS_BCAT);
    constexpr size_t PER = (size_t)512 * 256 / 4;
    for (size_t i = C.gt; i < (size_t)OG_SEQ * 8 * PER; i += C.NGT) {
        const int sh = (int)(i / PER), h = sh & 7; const size_t rem = i % PER; const int dv = (int)(rem >> 6), dk = (int)(rem & 63) * 4;
        const float gC = exp2f(256.0f * l2gamma(h));
        f32x4 f = (f32x4){0.f, 0.f, 0.f, 0.f};
        for (int n = 0; n < 16; ++n) { const size_t item = (size_t)sh * 16 + n;
            u32x2 w; w.x = pk2(f[0], f[1]); w.y = pk2(f[2], f[3]); *(u32x2*)(BC + (item * 512 + dv) * CATK + 256 + dk) = w;
            f = f * gC + *(const f32x4*)(KVF + (item * 512 + dv) * 256 + dk); }
        f = (f32x4){0.f, 0.f, 0.f, 0.f};
        for (int n = 15; n >= 0; --n) { const size_t item = (size_t)sh * 16 + n;
            u32x2 w; w.x = pk2(f[0], f[1]); w.y = pk2(f[2], f[3]); *(u32x2*)(BC + (item * 512 + dv) * CATK + 512 + dk) = w;
            f = f * gC + *(const f32x4*)(KVB + (item * 512 + dv) * 256 + dk); }
    }
}

DI void phase_ret_post(const Ctx& C, const Args& A, int e) {
    const float* Y = (const float*)(A.ws + WS_Y); const bf16_t* GS = (const bf16_t*)(A.ws + WS_GS); bf16_t* OB = (bf16_t*)(A.ws + WS_OB);
    const float* gg = A.in[17] + (size_t)e * C_V; const float* gb = A.in[18] + (size_t)e * C_V;
    for (int task = C.gw; task < OG_T * 8; task += C.NGW) {
        const int t = task >> 3, h = task & 7; const size_t off = (size_t)t * C_V + h * 512 + C.lane * 8;
        const f32x4 a = *(const f32x4*)(Y + off), b = *(const f32x4*)(Y + off + 4);
        const float mu = wave_sum((a[0] + a[1]) + (a[2] + a[3]) + (b[0] + b[1]) + (b[2] + b[3])) * (1.f / 512.f);
        const f32x4 da = a - mu, db = b - mu;
        const float var = wave_sum((da[0] * da[0] + da[1] * da[1]) + (da[2] * da[2] + da[3] * da[3]) + (db[0] * db[0] + db[1] * db[1]) + (db[2] * db[2] + db[3] * db[3])) * (1.f / 512.f);
        const float rs = 1.0f / sqrtf(var + LN_EPS);
        const int cc = h * 512 + C.lane * 8;
        const f32x4 g0 = *(const f32x4*)(gg + cc), g1 = *(const f32x4*)(gg + cc + 4), b0 = *(const f32x4*)(gb + cc), b1 = *(const f32x4*)(gb + cc + 4);
        float gs[8]; unpack8(*(const u32x4*)(GS + off), gs);
        const f32x4 o0 = (da * rs * g0 + b0), o1 = (db * rs * g1 + b1);
        u32x4 w; w.x = pk2(o0[0] * gs[0], o0[1] * gs[1]); w.y = pk2(o0[2] * gs[2], o0[3] * gs[3]); w.z = pk2(o1[0] * gs[4], o1[1] * gs[5]); w.w = pk2(o1[2] * gs[6], o1[3] * gs[7]);
        *(u32x4*)(OB + off) = w;
    }
}

DI bool step_ctx(Ctx& C, const Ctx& B) {
    int bid = B.bid, G = B.G, tid = B.tid;
    asm volatile("" : "+s"(bid), "+s"(G), "+v"(tid));
    C.lds = B.lds; C.tid = tid; C.lane = tid & 63; C.wave = __builtin_amdgcn_readfirstlane(tid >> 6); C.G = G; C.bid = bid;
    C.gw = bid * NWAVES + C.wave; C.NGW = G * NWAVES; C.gt = (size_t)bid * (NWAVES * 64) + tid; C.NGT = (size_t)G * NWAVES * 64;
    return true;
}
constexpr int N_STEPS = 1 + 2 * (1 + 8 + 4) + 2 * (1 + 7 * OG_N + 4);
__global__ void __launch_bounds__(NWAVES * 64, 2) mk_fwd(Args args) {
    extern __shared__ __attribute__((aligned(16))) unsigned char lds_raw[];
    Ctx C;
    C.lds = (LAS unsigned char*)lds_raw;
    C.tid = threadIdx.x; C.lane = C.tid & 63; C.wave = __builtin_amdgcn_readfirstlane(C.tid >> 6);
    C.G = gridDim.x; C.bid = blockIdx.x;
    C.gw = C.bid * NWAVES + C.wave; C.NGW = C.G * NWAVES;
    C.gt = (size_t)C.bid * (NWAVES * 64) + C.tid; C.NGT = (size_t)C.G * NWAVES * 64;
    volatile LAS unsigned* MISC = (volatile LAS unsigned*)(C.lds + MISC_OFF);
    for (int u = C.tid; u < (LDS_BYTES - LDSCTL_OFF) / 4; u += NWAVES * 64) ((LAS unsigned*)(C.lds + LDSCTL_OFF))[u] = 0u;
    __syncthreads();
    const int lo = args.lo, hi = args.hi;
    unsigned* barw = (unsigned*)(args.ws + WS_CTL) + CW_BAR;
    XcdBarrier bar; bar.bar = barw; bar.x = 0; bar.st = MISC + 8;
    if (hi - lo > 1) bar = xcd_barrier_post(barw, MISC + 8);
    LAS unsigned char* ring = C.lds;
    const Ctx Cb = C;
    int step = 0;
#define STEP_IF(kind) if (step >= lo && step < hi) for (int rep_ = 0; rep_ < 1 + (int)((PROBE_REP_MASK >> (kind)) & 1u); ++rep_) if (unsigned char* ws = opaque_ptr(args.ws)) if (step_ctx(C, Cb))
#define STEP_END do { if (step >= lo && step + 1 < hi) xcd_barrier(bar); ++step; } while (0)

    STEP_IF(0) { phase_init(C, args); } STEP_END;
    for (int l = 0; l < DEPTH; ++l) {
        const int e = l >> 1;
        STEP_IF(1) { phase_wprep(C, args, l); } STEP_END;
        if (!(l & 1)) {
            STEP_IF(2) {
                { pg8::FlatOrder S; S.init(ws + WS_XB, ws + WE_IN, D, D, T, A_COLS + 2048, C.G, C.bid);
                  EpiBf16Split E{(bf16_t*)(ws + WS_HA), A_COLS, (bf16_t*)(ws + WS_HB), 2048, A_COLS / 256};
                  pg8::gemm_phase(ring, pg8::Gemm{D, D, D}, S, E, C.tid); }
                { pg8::FlatOrder S; S.init(ws + WE_IN + (size_t)(A_COLS + 2048) * D * 2, ws + WS_XB, D, D, 1024, T, C.G, C.bid);
                  EpiBf16Split E{(bf16_t*)(ws + WS_VT), T, (bf16_t*)(ws + WS_VT), T, 1 << 20};
                  pg8::gemm_phase(ring, pg8::Gemm{D, D, D}, S, E, C.tid); }
            } STEP_END;
            STEP_IF(3) { phase_na(C, args, e); } STEP_END;
            STEP_IF(4) { phase_conv_a(C, args, e); } STEP_END;
            STEP_IF(5) {
                pg8::FlatOrder S; S.init(ws + WS_LIN, ws + WE_LORA, LORA_K, LORA_K, T, LORA_N, C.G, C.bid);
                EpiLora E{(unsigned short*)(ws + WS_EWA), (unsigned short*)(ws + WS_GATE), args.in[4] + (size_t)e * 2 * A_W, args.in[6] + (size_t)e * 2 * A_W};
                pg8::gemm_phase(ring, pg8::Gemm{LORA_K, LORA_K, LORA_K}, S, E, C.tid);
            } STEP_END;
            STEP_IF(6) { phase_scan(C, args, e); } STEP_END;
            STEP_IF(7) { phase_rwkv_post(C, args, e); } STEP_END;
            STEP_IF(8) {
                pg8::FlatOrder S; S.init(ws + WS_YAB, ws + WE_OUT, D, D, T, D, C.G, C.bid);
                EpiResF32 E{args.out, D, DN_ALPHA};
                pg8::gemm_phase(ring, pg8::Gemm{D, D, D}, S, E, C.tid);
            } STEP_END;
            STEP_IF(9) { phase_ln(C, args, 0, T, args.in[20] + (size_t)l * D, args.in[21] + (size_t)l * D); } STEP_END;
        } else {
            for (int g = 0; g < OG_N; ++g) {
                const size_t row0 = (size_t)g * OG_T;
                STEP_IF(10) {
                    { pg8::FlatOrder S; S.init(ws + WS_XB + row0 * D * 2, ws + WO_IN, D, D, OG_T, 8192, C.G, C.bid);
                      EpiO1a E{(bf16_t*)(ws + WS_QN), (bf16_t*)(ws + WS_KN), (bf16_t*)(ws + WS_GS), (bf16_t*)(ws + WS_ACAT), (const float*)(ws + WS_ROPE_N)};
                      pg8::gemm_phase(ring, pg8::Gemm{D, D, D}, S, E, C.tid); }
                    { pg8::FlatOrder S; S.init(ws + WO_IN + (size_t)8192 * D * 2, ws + WS_XB + row0 * D * 2, D, D, 6144, OG_T, C.G, C.bid);
                      EpiO1b E{(bf16_t*)(ws + WS_KTF), (bf16_t*)(ws + WS_KTB), (bf16_t*)(ws + WS_BCAT), (const float*)(ws + WS_ROPE_T)};
                      pg8::gemm_phase(ring, pg8::Gemm{D, D, D}, S, E, C.tid); }
                } STEP_END;
                STEP_IF(11) {
                    { RetOrder<0> S{(const char*)(ws + WS_QN), (const char*)(ws + WS_KN), C.G, C.bid}; EpiO2 E{(bf16_t*)(ws + WS_ACAT)};
                      pg8::gemm_phase(ring, pg8::Gemm{C_QK, C_QK, 256}, S, E, C.tid); }
                    { RetOrder<1> S{(const char*)(ws + WS_BCAT), (const char*)(ws + WS_KTF), C.G, C.bid}; EpiKV E{(float*)(ws + WS_KVF)};
                      pg8::gemm_phase(ring, pg8::Gemm{CATK, OG_T, 256}, S, E, C.tid); }
                    { RetOrder<1> S{(const char*)(ws + WS_BCAT), (const char*)(ws + WS_KTB), C.G, C.bid}; EpiKV E{(float*)(ws + WS_KVB)};
                      pg8::gemm_phase(ring, pg8::Gemm{CATK, OG_T, 256}, S, E, C.tid); }
                } STEP_END;
                STEP_IF(12) { phase_ret_scan(C, args); } STEP_END;
                STEP_IF(13) { RetOrder<2> S{(const char*)(ws + WS_ACAT), (const char*)(ws + WS_BCAT), C.G, C.bid}; EpiY E{(float*)(ws + WS_Y)};
                          pg8::gemm_phase(ring, pg8::Gemm{CATK, CATK, CATK}, S, E, C.tid); } STEP_END;
                STEP_IF(14) { phase_ret_post(C, args, e); } STEP_END;
                STEP_IF(15) { pg8::FlatOrder S; S.init(ws + WS_OB, ws + WO_OUT, C_V, C_V, OG_T, D, C.G, C.bid);
                          EpiResF32 E{args.out + row0 * D, D, DN_ALPHA};
                          pg8::gemm_phase(ring, pg8::Gemm{C_V, C_V, C_V}, S, E, C.tid); } STEP_END;
                STEP_IF(9) { phase_ln(C, args, (int)row0, OG_T, args.in[20] + (size_t)l * D, args.in[21] + (size_t)l * D); } STEP_END;
            }
        }
        {
            const size_t wup = (l & 1) ? WO_UP : WE_UP, wdn = (l & 1) ? WO_DN : WE_DN;
            STEP_IF(16) { pg8::FlatOrder S; S.init(ws + WS_XB, ws + wup, D, D, T, FF2, C.G, C.bid);
                      EpiFfnAct E{(bf16_t*)(ws + WS_ACT), (float*)(ws + WS_EDGE), args.in[23] + (size_t)l * 3 * D_FF, args.in[24] + (size_t)l * D_FF, (LAS float*)(C.lds + EB_OFF)};
                      pg8::gemm_phase(ring, pg8::Gemm{D, D, D}, S, E, C.tid); } STEP_END;
            STEP_IF(17) { phase_ffn_fix(C, args, l); } STEP_END;
            STEP_IF(18) { pg8::FlatOrder S; S.init(ws + WS_ACT, ws + wdn, D_FF, D_FF, T, D, C.G, C.bid);
                      EpiResF32 E{args.out, D, DN_ALPHA};
                      pg8::gemm_phase(ring, pg8::Gemm{D_FF, D_FF, D_FF}, S, E, C.tid); } STEP_END;
            STEP_IF(9) { phase_ln(C, args, 0, T, args.in[26] + (size_t)l * D, args.in[27] + (size_t)l * D); } STEP_END;
        }
    }
#undef STEP_IF
#undef STEP_END
}

extern "C" void kernel_launch(void* const* d_in, const int* in_sizes, int n_in, void* d_out, int out_size, void* d_ws, size_t ws_size, hipStream_t stream) {
    static int grid = 0;
    if (grid == 0) {
        if (n_in != 28 || out_size != T * D || ws_size < WS_NEED) { fprintf(stderr, "kernel_launch: unexpected shapes: n_in %d out %d ws %zu (need %zu)\n", n_in, out_size, ws_size, (size_t)WS_NEED); grid = -1; return; }
        int dev = 0, cus = 0, per_cu = 0;
        if (hipGetDevice(&dev) != hipSuccess || hipDeviceGetAttribute(&cus, hipDeviceAttributeMultiprocessorCount, dev) != hipSuccess) { grid = -1; return; }
        if (hipFuncSetAttribute((const void*)mk_fwd, hipFuncAttributeMaxDynamicSharedMemorySize, LDS_BYTES) != hipSuccess) { fprintf(stderr, "kernel_launch: hipFuncSetAttribute failed\n"); grid = -1; return; }
        if (hipOccupancyMaxActiveBlocksPerMultiprocessor(&per_cu, (const void*)mk_fwd, NWAVES * 64, LDS_BYTES) != hipSuccess || per_cu < 1) fprintf(stderr, "kernel_launch: occupancy query says %d\n", per_cu);
        (void)hipGetLastError();
        grid = cus;
    }
    if (grid < 0) return;
    (void)in_sizes;
    hipMemsetAsync((char*)d_ws + WS_CTL, 0, CTL_ZERO_BYTES, stream);
    Args a{};
    for (int i = 0; i < 28; ++i) a.in[i] = (const float*)d_in[i];
    a.out = (float*)d_out; a.ws = (unsigned char*)d_ws;
#if MK_MULTI_LAUNCH
    for (int s = 0; s < N_STEPS; ++s) { a.lo = s; a.hi = s + 1; hipLaunchKernelGGL(mk_fwd, dim3(grid), dim3(NWAVES * 64), LDS_BYTES, stream, a); }
#else
    a.lo = 0; a.hi = N_STEPS;
    hipLaunchKernelGGL(mk_fwd, dim3(grid), dim3(NWAVES * 64), LDS_BYTES, stream, a);
#endif
}
```
